# Optimizing an MI355X kernel written in HIP

```python
import math
import jax, jax.numpy as jnp
from jax import lax
import numpy as np

D_MODEL = 2048
BATCH = 4
SEQ = 2048
DEPTH = 4
DEC_BATCH = 32
DEC_SEQ = 8
PAST_LEN = 16384
PAGE_SIZE = 128

N_META = 16
D_MIX = D_MODEL
D_ATTN = D_MIX // 2
D_REC = D_MIX - D_ATTN
HEAD_DIM = 64
N_HEADS = D_ATTN // HEAD_DIM
N_KV = 4
GROUP = N_HEADS // N_KV
KV_DIM = N_KV * HEAD_DIM
WINDOW = 128
ATT_BLOCK = 128
N_BUCKETS = 32
MAX_DISTANCE = 128
REC_HEAD_DIM = 128
N_REC_HEADS = D_REC // REC_HEAD_DIM
REC_CHUNK = 64
EPS = 1e-6
D_IN = 2 * D_ATTN + 2 * KV_DIM + 4 * D_REC
SPLITS = (D_ATTN, D_ATTN + KV_DIM, D_ATTN + 2 * KV_DIM, 2 * D_ATTN + 2 * KV_DIM,
          2 * D_ATTN + 2 * KV_DIM + D_REC, 2 * D_ATTN + 2 * KV_DIM + 2 * D_REC,
          2 * D_ATTN + 2 * KV_DIM + 3 * D_REC)

kernel_name = 'hymba_swa_sink_hgrn2_decoder_step'


def rmsnorm(x, w):
    xf = x.astype(jnp.float32)
    y = xf * lax.rsqrt(jnp.mean(xf * xf, axis=-1, keepdims=True) + EPS)
    return y.astype(x.dtype) * w


def t5_bucket(dist):
    max_exact = N_BUCKETS // 2
    d = jnp.maximum(dist, 0)
    df = jnp.maximum(d, 1).astype(jnp.float32)
    large = max_exact + (jnp.log(df / max_exact) / math.log(MAX_DISTANCE / max_exact)
                         * (N_BUCKETS - max_exact)).astype(jnp.int32)
    large = jnp.minimum(large, N_BUCKETS - 1)
    return jnp.where(d < max_exact, d, large)


def sink_softmax(s, sink):
    sk = sink.astype(jnp.float32)[:, :, None, None]
    m = jnp.maximum(jnp.max(s, axis=-1, keepdims=True), sk)
    e = jnp.exp(s - m)
    return e / (jnp.sum(e, axis=-1, keepdims=True) + jnp.exp(sk - m))


def project(h, norm_w, w_in, lb):
    B, T = h.shape[0], h.shape[1]
    z = rmsnorm(h, norm_w) @ w_in
    qa, ka, va, ga, qr, fr, ir, gr = jnp.split(z, SPLITS, axis=-1)
    qa = qa.reshape(B, T, N_HEADS, HEAD_DIM)
    ka = ka.reshape(B, T, N_KV, HEAD_DIM)
    va = va.reshape(B, T, N_KV, HEAD_DIM)
    fr32 = fr.astype(jnp.float32)
    lb32 = lb.astype(jnp.float32)
    logf = jnp.log(lb32 + (1.0 - lb32) * jax.nn.sigmoid(fr32)).reshape(B, T, N_REC_HEADS, REC_HEAD_DIM)
    kr = ((1.0 - lb32) * jax.nn.sigmoid(-fr32)).reshape(B, T, N_REC_HEADS, REC_HEAD_DIM)
    qr = jax.nn.silu(qr).reshape(B, T, N_REC_HEADS, REC_HEAD_DIM)
    ir = ir.reshape(B, T, N_REC_HEADS, REC_HEAD_DIM)
    return qa, ka, va, ga, qr, logf, kr, ir, gr


def swa_prompt(q, k, v, sinks, bias_d):
    B, L = q.shape[0], q.shape[1]
    pad = (-L) % ATT_BLOCK
    padf = lambda a: jnp.pad(a, ((0, 0), (pad, 0), (0, 0), (0, 0)))
    nb = (L + pad) // ATT_BLOCK
    qb = padf(q).reshape(B, nb, ATT_BLOCK, N_KV, GROUP, HEAD_DIM)
    kb = padf(k).reshape(B, nb, ATT_BLOCK, N_KV, HEAD_DIM)
    vb = padf(v).reshape(B, nb, ATT_BLOCK, N_KV, HEAD_DIM)
    prev = lambda a: jnp.concatenate([jnp.zeros_like(a[:, :1]), a[:, :-1]], axis=1)
    kk = jnp.concatenate([prev(kb), kb], axis=2)
    vv = jnp.concatenate([prev(vb), vb], axis=2)
    s = jnp.einsum('bnqkgd,bnskd->bnkgqs', qb, kk,
                   preferred_element_type=jnp.float32) * (HEAD_DIM ** -0.5)
    qi = jnp.arange(ATT_BLOCK)
    sj = jnp.arange(2 * ATT_BLOCK)
    dist = ATT_BLOCK + qi[:, None] - sj[None, :]
    kpos = (jnp.arange(nb)[:, None] - 1) * ATT_BLOCK + sj[None, :] - pad
    valid = ((dist >= 0) & (dist < WINDOW))[None] & (kpos >= 0)[:, None, :]
    bias = bias_d[:, jnp.clip(dist, 0, WINDOW - 1)].reshape(N_KV, GROUP, ATT_BLOCK, 2 * ATT_BLOCK)
    s = jnp.where(valid[None, :, None, None], s + bias, -jnp.inf)
    p = sink_softmax(s, sinks.reshape(N_KV, GROUP))
    o = jnp.einsum('bnkgqs,bnskd->bnqkgd', p.astype(v.dtype), vv)
    return o.reshape(B, nb * ATT_BLOCK, N_HEADS, HEAD_DIM)[:, pad:]


def swa_sample(q, k_new, v_new, k_buf, v_buf, sinks, bias_d):
    Bd, T = q.shape[0], q.shape[1]
    W = k_buf.shape[1]
    kk = jnp.concatenate([k_buf.astype(k_new.dtype), k_new], axis=1)
    vv = jnp.concatenate([v_buf.astype(v_new.dtype), v_new], axis=1)
    qg = q.reshape(Bd, T, N_KV, GROUP, HEAD_DIM)
    s = jnp.einsum('btkgd,bskd->bkgts', qg, kk,
                   preferred_element_type=jnp.float32) * (HEAD_DIM ** -0.5)
    kpos = jnp.arange(W + T) - W
    dist = jnp.arange(T)[:, None] - kpos[None, :]
    valid = (dist >= 0) & (dist < WINDOW)
    bias = bias_d[:, jnp.clip(dist, 0, WINDOW - 1)].reshape(N_KV, GROUP, T, W + T)
    s = jnp.where(valid, s + bias, -jnp.inf)
    p = sink_softmax(s, sinks.reshape(N_KV, GROUP))
    o = jnp.einsum('bkgts,bskd->btkgd', p.astype(v_new.dtype), vv).reshape(Bd, T, N_HEADS, HEAD_DIM)
    return o, kk[:, -W:], vv[:, -W:]


def hgrn2_chunked(q, logf, k, v, s0):
    B, T = q.shape[0], q.shape[1]
    C = min(REC_CHUNK, T)
    pad = (-T) % C
    padf = lambda a: jnp.pad(a.astype(jnp.float32), ((0, 0), (pad, 0), (0, 0), (0, 0)))
    nc = (T + pad) // C
    to_chunks = lambda a: padf(a).reshape(B, nc, C, N_REC_HEADS, a.shape[-1]).transpose(1, 0, 3, 2, 4)
    qs, gs, ks, vs = to_chunks(q), to_chunks(logf), to_chunks(k), to_chunks(v)
    tril = jnp.tril(jnp.ones((C, C), dtype=bool))

    def step(S, inp):
        qc, gc, kc, vc = inp
        A = jnp.cumsum(gc, axis=2)
        A_last = A[:, :, -1:]
        diff = A[:, :, :, None, :] - A[:, :, None, :, :]
        decay = jnp.exp(jnp.where(tril[:, :, None], diff, -jnp.inf))
        attn = jnp.einsum('bhtd,bhtsd,bhsd->bhts', qc, decay, kc)
        o = jnp.einsum('bhts,bhsv->bhtv', attn, vc) + jnp.einsum('bhtd,bhdv->bhtv', qc * jnp.exp(A), S)
        S_new = jnp.exp(A_last)[:, :, 0, :, None] * S + jnp.einsum('bhsd,bhsv->bhdv', kc * jnp.exp(A_last - A), vc)
        return S_new, o

    s_fin, o = lax.scan(step, s0.astype(jnp.float32), (qs, gs, ks, vs))
    o = o.transpose(1, 0, 3, 2, 4).reshape(B, nc * C, N_REC_HEADS, REC_HEAD_DIM)[:, pad:]
    return o.astype(v.dtype), s_fin


def mix_out(h, oa, ga, orec, gr, rec_norm_w, w_out):
    B, T = h.shape[0], h.shape[1]
    ya = oa.reshape(B, T, D_ATTN) * jax.nn.silu(ga)
    of = orec.astype(jnp.float32)
    on = (of * lax.rsqrt(jnp.mean(of * of, axis=-1, keepdims=True) + EPS)).astype(h.dtype)
    yr = (on * rec_norm_w.reshape(N_REC_HEADS, REC_HEAD_DIM)).reshape(B, T, D_REC) * jax.nn.silu(gr)
    return h + jnp.concatenate([ya, yr], axis=-1) @ w_out


def setup_inputs(seed: int = 0) -> dict:
    key = jax.random.key(seed)
    ks = jax.random.split(key, 14)
    nrm = jax.random.normal
    win = min(WINDOW, PAST_LEN)
    return {
        'x_prompt': nrm(ks[0], (BATCH, SEQ, D_MODEL), jnp.float32),
        'x_sample': nrm(ks[1], (DEC_BATCH, DEC_SEQ, D_MODEL), jnp.float32),
        'cache_k': nrm(ks[2], (DEPTH, DEC_BATCH, win, N_KV, HEAD_DIM), jnp.float32),
        'cache_v': nrm(ks[3], (DEPTH, DEC_BATCH, win, N_KV, HEAD_DIM), jnp.float32),
        'state_h': 0.5 * nrm(ks[4], (DEPTH, DEC_BATCH, N_REC_HEADS, REC_HEAD_DIM, REC_HEAD_DIM), jnp.float32),
        'meta_tokens': nrm(ks[5], (N_META, D_MODEL), jnp.float32),
        'w_in': nrm(ks[6], (DEPTH, D_MODEL, D_IN), jnp.float32) * D_MODEL ** -0.5,
        'w_out': nrm(ks[7], (DEPTH, D_MIX, D_MODEL), jnp.float32) * D_MIX ** -0.5,
        'norm_w': 1.0 + 0.01 * nrm(ks[8], (DEPTH, D_MODEL), jnp.float32),
        'final_norm_w': 1.0 + 0.01 * nrm(ks[9], (D_MODEL,), jnp.float32),
        'attn_sinks': 0.5 * nrm(ks[10], (DEPTH, N_HEADS), jnp.float32),
        'rel_bias_table': 0.5 * nrm(ks[11], (N_BUCKETS, N_HEADS), jnp.float32),
        'hgrn_lb_logits': 0.5 * nrm(ks[12], (DEPTH, D_REC), jnp.float32),
        'hgrn_norm_w': 1.0 + 0.01 * nrm(ks[13], (DEPTH, D_REC), jnp.float32),
    }


def reference(x_prompt, x_sample, cache_k, cache_v, state_h, meta_tokens, w_in, w_out, norm_w,
              final_norm_w, attn_sinks, rel_bias_table, hgrn_lb_logits, hgrn_norm_w):
    B = x_prompt.shape[0]
    meta = jnp.broadcast_to(meta_tokens[None].astype(x_prompt.dtype), (B, N_META, D_MODEL))
    hp = jnp.concatenate([meta, x_prompt], axis=1)
    hs = x_sample
    bias_d = rel_bias_table[t5_bucket(jnp.arange(WINDOW))].T.astype(jnp.float32)
    pl = jax.nn.softmax(hgrn_lb_logits.astype(jnp.float32), axis=0)
    lb_all = jnp.cumsum(pl, axis=0) - pl[0:1]
    win = cache_k.shape[2]
    pk, pv, ps, sk, sv, ss = [], [], [], [], [], []
    for l in range(DEPTH):
        qa, ka, va, ga, qr, logf, kr, ir, gr = project(hp, norm_w[l], w_in[l], lb_all[l])
        oa = swa_prompt(qa, ka, va, attn_sinks[l], bias_d)
        s0 = jnp.zeros((B, N_REC_HEADS, REC_HEAD_DIM, REC_HEAD_DIM), jnp.float32)
        orec, sp = hgrn2_chunked(qr, logf, kr, ir, s0)
        hp = mix_out(hp, oa, ga, orec, gr, hgrn_norm_w[l], w_out[l])
        pk.append(ka[:, -win:])
        pv.append(va[:, -win:])
        ps.append(sp.astype(state_h.dtype))
        qa, ka, va, ga, qr, logf, kr, ir, gr = project(hs, norm_w[l], w_in[l], lb_all[l])
        oa, kbuf, vbuf = swa_sample(qa, ka, va, cache_k[l], cache_v[l], attn_sinks[l], bias_d)
        orec, s_s = hgrn2_chunked(qr, logf, kr, ir, state_h[l])
        hs = mix_out(hs, oa, ga, orec, gr, hgrn_norm_w[l], w_out[l])
        sk.append(kbuf)
        sv.append(vbuf)
        ss.append(s_s.astype(state_h.dtype))
    y_prompt = rmsnorm(hp[:, N_META:], final_norm_w)
    y_sample = rmsnorm(hs, final_norm_w)
    return (y_prompt, y_sample, jnp.stack(pk), jnp.stack(pv), jnp.stack(ps),
            jnp.stack(sk), jnp.stack(sv), jnp.stack(ss))
```

```cpp
#include <hip/hip_runtime.h>
#include <cstdio>
#include <cstdint>

#ifndef MK_SINGLE
#define MK_SINGLE 1
#endif

#define LAS __attribute__((address_space(3)))
typedef unsigned short bf16_t;
typedef short bf16x8 __attribute__((ext_vector_type(8)));
typedef float f32x4 __attribute__((ext_vector_type(4)));
typedef float f32x2 __attribute__((ext_vector_type(2)));
typedef unsigned u32x4 __attribute__((ext_vector_type(4)));
typedef unsigned u32x2 __attribute__((ext_vector_type(2)));

constexpr int DM = 2048, NBATCH = 4, SEQ = 2048, NMETA = 16, LP = SEQ + NMETA;
constexpr int MPR = NBATCH * LP;
constexpr int DBATCH = 32, DSEQ = 8, MSA = DBATCH * DSEQ;
constexpr int MTOT = MPR + MSA;
constexpr int MPAD = 8704;
constexpr int DIN = 6656, DEPTH = 4, WIN = 128;
constexpr int NCH = 33;
constexpr int NUNIT = NBATCH * 8 * NCH;
constexpr float EPS = 1e-6f;

constexpr size_t O_YP = 0, O_YS = 16777216, O_PCK = 17301504, O_PCV = 17825792, O_PSH = 18350080, O_SCK = 20447232, O_SCV = 24641536, O_SSH = 28835840;

constexpr size_t MiB = 1u << 20;
constexpr size_t WS_CTL = 0, CTL_ZERO_BYTES = 1 * MiB;
constexpr size_t WS_SSQ = 512 * 1024;
constexpr size_t WS_LB = 1 * MiB;
constexpr size_t WS_BIAS = WS_LB + 16384;
constexpr size_t WS_WIN = 2 * MiB;
constexpr size_t WS_WOUT = WS_WIN + (size_t)DEPTH * DIN * DM * 2;
constexpr size_t WS_H = WS_WOUT + (size_t)DEPTH * DM * DM * 2;
constexpr size_t WS_HB = WS_H + (size_t)MPAD * DM * 4;
constexpr size_t WS_Q = WS_HB + (size_t)MPAD * DM * 2;
constexpr size_t SZ1K = (size_t)MPAD * 1024 * 2;
constexpr size_t WS_GA = WS_Q + SZ1K, WS_QR = WS_GA + SZ1K, WS_KR = WS_QR + SZ1K, WS_IR = WS_KR + SZ1K, WS_GR = WS_IR + SZ1K;
constexpr size_t WS_KB = WS_GR + SZ1K;
constexpr size_t WS_VB = WS_KB + (size_t)MPAD * 256 * 2;
constexpr size_t WS_LOGF = WS_VB + (size_t)MPAD * 256 * 2;
constexpr size_t WS_Y = WS_LOGF + (size_t)MPAD * 1024 * 4;
constexpr size_t WS_UT = WS_Y + (size_t)MPAD * DM * 2;
constexpr size_t WS_GD = WS_UT + (size_t)NUNIT * 16384 * 4;
constexpr size_t WS_STB = WS_GD + (size_t)NUNIT * 128 * 4;
constexpr size_t WS_END = WS_STB + (size_t)NUNIT * 16384 * 2;
constexpr int CW_BAR = 4096;

constexpr int NWAVES = 8, NTHR = 512;
constexpr int LDS_BYTES = 147456;
constexpr int RING_BYTES = 131072;
constexpr int MISC_OFF = LDS_BYTES - 256;

#define WSP(T, off) ((T*)(ws + (off)))
#define LDS_WAIT() asm volatile("s_waitcnt lgkmcnt(0)" ::: "memory")
#define VM_WAIT() asm volatile("s_waitcnt vmcnt(0)" ::: "memory")

__device__ __forceinline__ unsigned f2bf(float f) { unsigned u = __builtin_bit_cast(unsigned, f); return (u + 0x7fffu + ((u >> 16) & 1u)) >> 16; }
__device__ __forceinline__ unsigned pk2(float lo, float hi) { return f2bf(lo) | (f2bf(hi) << 16); }
__device__ __forceinline__ float bf2f(unsigned short b) { return __builtin_bit_cast(float, (unsigned)b << 16); }
__device__ __forceinline__ float bflo(unsigned w) { return __builtin_bit_cast(float, w << 16); }
__device__ __forceinline__ float bfhi(unsigned w) { return __builtin_bit_cast(float, w & 0xffff0000u); }
__device__ __forceinline__ int opq(int x) { asm volatile("" : "+v"(x)); return x; }
__device__ __forceinline__ float silu_f(float x) { return x * __frcp_rn(1.f + __expf(-x)); }

namespace pg8 {
constexpr int BM = 256, BK = 64, HALF = 128, HTB = HALF * BK * 2, STAGE_BYTES = 8 * HTB, NXCD = 8, WGM = 8;
__host__ __device__ __forceinline__ int lds_byte(int r, int c) { const int st = (r >> 4) * 2 + (c >> 5), rr = r & 15, cc = c & 31, ob = rr * 64 + cc * 2; return st * 1024 + (ob ^ (((ob >> 9) & 1) << 5)); }
__host__ __device__ __forceinline__ void stage_rc(int b, int& R, int& C) { const int st = b / 1024, sb = b % 1024, swz = sb ^ (((sb >> 9) & 1) << 5); R = (st >> 1) * 16 + swz / 64; C = (st & 1) * 32 + (swz % 64) / 2; }
__host__ __device__ __forceinline__ int perm32(int rho) { const int n = rho >> 4, i = rho & 15; return 8 * (i >> 2) + 4 * n + (i & 3); }

struct Unit { int pm, pn; };
struct Gemm { const bf16_t* A; const bf16_t* Bt; int M, N, K; };

struct StaticOrder {
    int nM, nN, nwg, G, c;
    __host__ __device__ void init(int M, int N, int G_, int c_) { nM = M / BM; nN = N / BM; nwg = nM * nN; G = G_; c = c_; }
    __host__ __device__ bool next(int i, Unit& u) const {
        const long L = (long)i * G + c; if (L >= nwg) return false;
        int wgid = (int)L; { const int q = nwg / NXCD, r = nwg % NXCD, xcd = wgid % NXCD, off = wgid / NXCD; wgid = (xcd < r ? xcd * (q + 1) : r * (q + 1) + (xcd - r) * q) + off; }
        const int nig = WGM * nN, gid = wgid / nig, fm = gid * WGM, gsz = (nM - fm) < WGM ? (nM - fm) : WGM;
        u.pm = fm + ((wgid % nig) % gsz); u.pn = (wgid % nig) / gsz; return true;
    }
    __device__ __forceinline__ void a_ready(const Unit&) const {}
    __device__ __forceinline__ void done(const Unit&) const {}
};

template <class Epi, class Sched>
__device__ __forceinline__ void gemm_phase(LAS unsigned char* lds, const Gemm g, const Sched& S, const Epi& E) {
    const int tid = opq((int)threadIdx.x), wid = __builtin_amdgcn_readfirstlane(tid >> 6), lane = tid & 63, wr = wid >> 2, wc = wid & 3, fr = lane & 15, fq = lane >> 4;
    const int K = g.K, nt = K / BK;
    unsigned voffA[2], voffB[2];
#pragma unroll
    for (int i = 0; i < 2; ++i) { int R, C; stage_rc(tid * 16 + i * 8192, R, C); const int Rb = Epi::PERM ? ((R & ~31) + perm32(R & 31)) : R;
        voffA[i] = (unsigned)(R * K + C) * 2u; voffB[i] = (unsigned)(Rb * K + C) * 2u; }
    const size_t kstep = (size_t)(BK * 2);
    const size_t hstep = (size_t)HALF * K * 2;
    const size_t tstep = 2 * hstep;
    const unsigned ldsw = (unsigned)wid * 1024u;
    const int aoff = lds_byte(wr * 64 + fr, fq * 8), boff = lds_byte(wc * 32 + fr, fq * 8);
#define PG8_SA(b, h) (((b) * 2 + (h)) * HTB)
#define PG8_SB(b, h) ((4 + (b) * 2 + (h)) * HTB)
#define PG8_STAGE(bufoff, gbase, voff) do { _Pragma("unroll") for (int _i = 0; _i < 2; ++_i) \
        __builtin_amdgcn_global_load_lds((const unsigned*)((const char*)(gbase) + (voff)[_i]), (LAS unsigned*)(lds + (bufoff) + ldsw + _i * 8192), 16, 0, 0); } while (0)
#define PG8_LDA(dst, b, h) do { _Pragma("unroll") for (int m = 0; m < 4; ++m) _Pragma("unroll") for (int k = 0; k < 2; ++k) dst[m][k] = *(const LAS bf16x8*)(lds + PG8_SA(b, h) + aoff + m * 2048 + k * 1024); } while (0)
#define PG8_LDB(dst, b, h) do { _Pragma("unroll") for (int n = 0; n < 2; ++n) _Pragma("unroll") for (int k = 0; k < 2; ++k) dst[n][k] = *(const LAS bf16x8*)(lds + PG8_SB(b, h) + boff + n * 2048 + k * 1024); } while (0)
#define PG8_MMA(ai, bj, At, Bt) do { __builtin_amdgcn_s_setprio(1); _Pragma("unroll") for (int m = 0; m < 4; ++m) _Pragma("unroll") for (int n = 0; n < 2; ++n) _Pragma("unroll") for (int k = 0; k < 2; ++k) \
        acc[ai][bj][m][n] = __builtin_amdgcn_mfma_f32_16x16x32_bf16(Bt[n][k], At[m][k], acc[ai][bj][m][n], 0, 0, 0); __builtin_amdgcn_s_setprio(0); } while (0)
#define PG8_WAIT_V(n) asm volatile("s_waitcnt vmcnt(" #n ")" ::: "memory")
#define PG8_WAIT_L(n) asm volatile("s_waitcnt lgkmcnt(" #n ")" ::: "memory")
#define PG8_BAR __builtin_amdgcn_s_barrier()
#define PG8_SCHED __builtin_amdgcn_sched_barrier(0)
    Unit cur, nxt; int ui = 0;
    if (!S.next(0, cur)) return;
    f32x4 acc[2][2][4][2];
#pragma unroll
    for (int a = 0; a < 2; ++a)
#pragma unroll
        for (int b = 0; b < 2; ++b)
#pragma unroll
            for (int m = 0; m < 4; ++m)
#pragma unroll
                for (int n = 0; n < 2; ++n) acc[a][b][m][n] = (f32x4){0.f, 0.f, 0.f, 0.f};
    bf16x8 At[4][2], B0[2][2], B1[2][2];
    const char* cA = (const char*)g.A + (size_t)cur.pm * tstep; const char* cB = (const char*)g.Bt + (size_t)cur.pn * tstep;
    S.a_ready(cur);
    PG8_STAGE(PG8_SB(0, 0), cB, voffB); PG8_STAGE(PG8_SB(0, 1), cB + hstep, voffB); PG8_STAGE(PG8_SA(0, 0), cA, voffA); PG8_STAGE(PG8_SA(0, 1), cA + hstep, voffA);
    if (wr == 1) PG8_BAR;
    PG8_WAIT_V(2); PG8_BAR;
    PG8_STAGE(PG8_SB(1, 0), cB + kstep, voffB); PG8_STAGE(PG8_SA(1, 0), cA + kstep, voffA); PG8_STAGE(PG8_SB(1, 1), cB + hstep + kstep, voffB);
    PG8_WAIT_V(6); PG8_BAR;
    for (;;) {
        const bool has_next = S.next(ui + 1, nxt);
        const char* nA = has_next ? (const char*)g.A + (size_t)nxt.pm * tstep : cA; const char* nB = has_next ? (const char*)g.Bt + (size_t)nxt.pn * tstep : cB;
        for (int t = 0; t < nt; t += 2) {
            const bool last = (t == nt - 2);
            const char* a1 = cA + (size_t)(t + 1) * kstep;
            const char* a2 = last ? nA : cA + (size_t)(t + 2) * kstep; const char* b2 = last ? nB : cB + (size_t)(t + 2) * kstep;
            const char* a3 = a2 + kstep; const char* b3 = b2 + kstep;
            if (last && has_next) S.a_ready(nxt);
            PG8_LDB(B0, 0, 0); PG8_LDB(B1, 0, 1); PG8_SCHED; PG8_LDA(At, 0, 0); PG8_STAGE(PG8_SA(1, 1), a1 + hstep, voffA);
            PG8_WAIT_V(8); PG8_WAIT_L(0); PG8_BAR; PG8_MMA(0, 0, At, B0); PG8_MMA(0, 1, At, B1); PG8_BAR; PG8_SCHED;
            PG8_LDA(At, 0, 1); PG8_STAGE(PG8_SB(0, 0), b2, voffB); PG8_STAGE(PG8_SB(0, 1), b2 + hstep, voffB); PG8_STAGE(PG8_SA(0, 0), a2, voffA);
            PG8_WAIT_V(8); PG8_WAIT_L(0); PG8_BAR; PG8_MMA(1, 0, At, B0); PG8_MMA(1, 1, At, B1); PG8_BAR; PG8_SCHED;
            PG8_LDB(B0, 1, 0); PG8_LDB(B1, 1, 1); PG8_SCHED; PG8_LDA(At, 1, 0); PG8_STAGE(PG8_SA(0, 1), a2 + hstep, voffA);
            PG8_WAIT_V(8); PG8_WAIT_L(0); PG8_BAR; PG8_MMA(0, 0, At, B0); PG8_MMA(0, 1, At, B1); PG8_BAR; PG8_SCHED;
            PG8_LDA(At, 1, 1); PG8_STAGE(PG8_SB(1, 0), b3, voffB); PG8_STAGE(PG8_SB(1, 1), b3 + hstep, voffB); PG8_STAGE(PG8_SA(1, 0), a3, voffA);
            PG8_WAIT_V(8); PG8_WAIT_L(0); PG8_BAR; PG8_MMA(1, 0, At, B0); PG8_MMA(1, 1, At, B1); PG8_BAR; PG8_SCHED;
        }
        if (wr == 0) PG8_BAR;
        E(acc, cur, wr, wc, fr, fq); S.done(cur);
        if (!has_next) break;
#pragma unroll
        for (int a = 0; a < 2; ++a)
#pragma unroll
            for (int b = 0; b < 2; ++b)
#pragma unroll
                for (int m = 0; m < 4; ++m)
#pragma unroll
                    for (int n = 0; n < 2; ++n) acc[a][b][m][n] = (f32x4){0.f, 0.f, 0.f, 0.f};
        cur = nxt; cA = nA; cB = nB; ++ui;
        if (wr == 1) PG8_BAR;
    }
    PG8_WAIT_V(0);
    PG8_BAR;
#undef PG8_SA
#undef PG8_SB
#undef PG8_STAGE
#undef PG8_LDA
#undef PG8_LDB
#undef PG8_MMA
#undef PG8_WAIT_V
#undef PG8_WAIT_L
#undef PG8_BAR
#undef PG8_SCHED
}
}

__device__ __forceinline__ u32x4 pack8(const f32x4 a, const f32x4 b) { u32x4 w; w.x = pk2(a[0], a[1]); w.y = pk2(a[2], a[3]); w.z = pk2(b[0], b[1]); w.w = pk2(b[2], b[3]); return w; }

struct EpiIn {
    static constexpr bool PERM = true;
    unsigned char* ws; float* out; int l;
    __device__ __forceinline__ void operator()(const f32x4 (&acc)[2][2][4][2], const pg8::Unit& u, int wr, int wc, int fr, int fq) const {
        const int pn = u.pn, row0 = u.pm * 256 + wr * 64 + fr, cw = wc * 32 + 8 * fq;
        const float* const ssq = WSP(const float, WS_SSQ) + l * MPAD;
        if (pn < 4 || (pn >= 6 && pn < 14) || pn >= 18) {
            bf16_t* base; int mode; int cb;
            if (pn < 4) { base = WSP(bf16_t, WS_Q); mode = 0; cb = pn * 256; }
            else if (pn < 10) { base = WSP(bf16_t, WS_GA); mode = 1; cb = (pn - 6) * 256; }
            else if (pn < 14) { base = WSP(bf16_t, WS_QR); mode = 1; cb = (pn - 10) * 256; }
            else if (pn < 22) { base = WSP(bf16_t, WS_IR); mode = 2; cb = (pn - 18) * 256; }
            else { base = WSP(bf16_t, WS_GR); mode = 1; cb = (pn - 22) * 256; }
#pragma unroll
            for (int ai = 0; ai < 2; ++ai)
#pragma unroll
                for (int m = 0; m < 4; ++m) { const int row = row0 + ai * 128 + m * 16; const float rs = rsqrtf(ssq[row] * (1.f / 2048.f) + EPS);
#pragma unroll
                    for (int bj = 0; bj < 2; ++bj) { f32x4 v0 = acc[ai][bj][m][0] * rs, v1 = acc[ai][bj][m][1] * rs;
                        if (mode == 0) { v0 = v0 * 0.125f; v1 = v1 * 0.125f; }
                        else if (mode == 1) {
#pragma unroll
                            for (int e = 0; e < 4; ++e) { v0[e] = silu_f(v0[e]); v1[e] = silu_f(v1[e]); } }
                        *(u32x4*)(base + (size_t)row * 1024 + cb + cw + bj * 128) = pack8(v0, v1); } }
        } else if (pn < 6) {
            bf16_t* base = pn == 4 ? WSP(bf16_t, WS_KB) : WSP(bf16_t, WS_VB); float* pc = out + (pn == 4 ? O_PCK : O_PCV) + (size_t)l * NBATCH * WIN * 256; float* sc = out + (pn == 4 ? O_SCK : O_SCV) + (size_t)l * DBATCH * WIN * 256;
#pragma unroll
            for (int ai = 0; ai < 2; ++ai)
#pragma unroll
                for (int m = 0; m < 4; ++m) { const int row = row0 + ai * 128 + m * 16; const float rs = rsqrtf(ssq[row] * (1.f / 2048.f) + EPS);
                    float* dst = nullptr;
                    if (row < MPR) { const int b = row / LP, t = row - b * LP; if (t >= LP - WIN) dst = pc + ((size_t)(b * WIN + t - (LP - WIN))) * 256; }
                    else if (row < MTOT) { const int rr = row - MPR; dst = sc + ((size_t)((rr >> 3) * WIN + (WIN - DSEQ) + (rr & 7))) * 256; }
#pragma unroll
                    for (int bj = 0; bj < 2; ++bj) { const f32x4 v0 = acc[ai][bj][m][0] * rs, v1 = acc[ai][bj][m][1] * rs; const int c = cw + bj * 128;
                        *(u32x4*)(base + (size_t)row * 256 + c) = pack8(v0, v1);
                        if (dst) { *(f32x4*)(dst + c) = v0; *(f32x4*)(dst + c + 4) = v1; } } }
        } else {
            const int cb = (pn - 14) * 256; const float* const lb = WSP(const float, WS_LB) + l * 1024; float* const LOGF = WSP(float, WS_LOGF); bf16_t* const KR = WSP(bf16_t, WS_KR);
            f32x4 l0[2], l1[2];
#pragma unroll
            for (int bj = 0; bj < 2; ++bj) { l0[bj] = *(const f32x4*)(lb + cb + cw + bj * 128); l1[bj] = *(const f32x4*)(lb + cb + cw + bj * 128 + 4); }
#pragma unroll
            for (int ai = 0; ai < 2; ++ai)
#pragma unroll
                for (int m = 0; m < 4; ++m) { const int row = row0 + ai * 128 + m * 16; const float rs = rsqrtf(ssq[row] * (1.f / 2048.f) + EPS);
#pragma unroll
                    for (int bj = 0; bj < 2; ++bj) { const f32x4 x0 = acc[ai][bj][m][0] * rs, x1 = acc[ai][bj][m][1] * rs; f32x4 f0, f1, k0, k1;
#pragma unroll
                        for (int e = 0; e < 4; ++e) {
                            { const float x = x0[e], lbv = l0[bj][e], sp = __frcp_rn(1.f + __expf(-x)), sn = __frcp_rn(1.f + __expf(x)); f0[e] = fmaxf(__logf(lbv + (1.f - lbv) * sp), -80.f); k0[e] = (1.f - lbv) * sn; }
                            { const float x = x1[e], lbv = l1[bj][e], sp = __frcp_rn(1.f + __expf(-x)), sn = __frcp_rn(1.f + __expf(x)); f1[e] = fmaxf(__logf(lbv + (1.f - lbv) * sp), -80.f); k1[e] = (1.f - lbv) * sn; } }
                        const size_t o = (size_t)row * 1024 + cb + cw + bj * 128;
                        *(f32x4*)(LOGF + o) = f0; *(f32x4*)(LOGF + o + 4) = f1; *(u32x4*)(KR + o) = pack8(k0, k1); } }
        }
    }
};

struct EpiOut {
    static constexpr bool PERM = true;
    unsigned char* ws; int l;
    __device__ __forceinline__ void operator()(const f32x4 (&acc)[2][2][4][2], const pg8::Unit& u, int wr, int wc, int fr, int fq) const {
        const int row0 = u.pm * 256 + wr * 64 + fr, c0 = u.pn * 256 + wc * 32 + 8 * fq;
        float* const H = WSP(float, WS_H); bf16_t* const HB = WSP(bf16_t, WS_HB); float* const ssq_next = WSP(float, WS_SSQ) + (l + 1) * MPAD;
#pragma unroll
        for (int ai = 0; ai < 2; ++ai)
#pragma unroll
            for (int m = 0; m < 4; ++m) { const int row = row0 + ai * 128 + m * 16; float s = 0.f;
#pragma unroll
                for (int bj = 0; bj < 2; ++bj) { float* hp = H + (size_t)row * DM + c0 + bj * 128;
                    f32x4 h0 = *(const f32x4*)hp, h1 = *(const f32x4*)(hp + 4); h0 = h0 + acc[ai][bj][m][0]; h1 = h1 + acc[ai][bj][m][1];
                    *(f32x4*)hp = h0; *(f32x4*)(hp + 4) = h1; *(u32x4*)(HB + (size_t)row * DM + c0 + bj * 128) = pack8(h0, h1);
                    s += (h0[0] * h0[0] + h0[1] * h0[1]) + (h0[2] * h0[2] + h0[3] * h0[3]) + (h1[0] * h1[0] + h1[1] * h1[1]) + (h1[2] * h1[2] + h1[3] * h1[3]); }
                s += __shfl_xor(s, 16); s += __shfl_xor(s, 32);
                if (fq == 0) __hip_atomic_fetch_add(ssq_next + row, s, __ATOMIC_RELAXED, __HIP_MEMORY_SCOPE_AGENT);
                asm volatile("" ::: "memory"); }
    }
};

#define XB_TMO      128
#define XB_XCNT(j)  (256  + 64 * (j))
#define XB_XSUB(j)  (1280 + 64 * (j))
#define XB_XGEN(j)  (2304 + 64 * (j))
#define XB_TOP      3328
#define XB_TOPGEN   3392
#define XCD_BAR_WORDS 3456
#define XB_SPIN_CAP (1u << 20)
__device__ __forceinline__ unsigned xb_ld(unsigned* p)              { return __hip_atomic_load(p, __ATOMIC_RELAXED, __HIP_MEMORY_SCOPE_AGENT); }
__device__ __forceinline__ unsigned xb_add(unsigned* p, unsigned v) { return __hip_atomic_fetch_add(p, v, __ATOMIC_RELAXED, __HIP_MEMORY_SCOPE_AGENT); }
__device__ __forceinline__ unsigned xb_xcc_id() { return (unsigned)__builtin_amdgcn_s_getreg((3 << 11) | 20) & 0xFu; }
#define XB_SPIN(cond, bar) do { unsigned _sp = 0; while (cond) { __builtin_amdgcn_s_sleep(1); \
    if ((++_sp & 255u) == 0u) { if (xb_ld(&(bar)[XB_TMO])) break; if (_sp > XB_SPIN_CAP) { atomicAdd(&(bar)[XB_TMO], 1u); break; } } } } while (0)
struct XcdBarrier { unsigned* bar; unsigned x; volatile LAS unsigned* st; };
__device__ __forceinline__ XcdBarrier xcd_barrier_post(unsigned* bar, volatile LAS unsigned* st) {
    XcdBarrier b; b.bar = bar; b.x = xb_xcc_id(); b.st = st;
    if (threadIdx.x == 0) (void)xb_add(&bar[XB_XCNT(b.x)], 1u);
    return b;
}
__device__ __forceinline__ void xcd_barrier_complete(unsigned* bar, unsigned x, unsigned& nloc, unsigned& nx) {
    const unsigned G = gridDim.x * gridDim.y * gridDim.z;
    unsigned sum, cnt, mine, sp = 0u;
    for (;;) {
        sum = 0u; cnt = 0u; mine = 0u;
#pragma unroll
        for (unsigned j = 0; j < 16; ++j) { const unsigned c = xb_ld(&bar[XB_XCNT(j)]); sum += c; cnt += (c > 0u) ? 1u : 0u; mine = (j == x) ? c : mine; }
        if (sum == G) break;
        __builtin_amdgcn_s_sleep(1);
        if ((++sp & 255u) == 0u) { if (xb_ld(&bar[XB_TMO])) break; if (sp > XB_SPIN_CAP) { atomicAdd(&bar[XB_TMO], 1u); break; } }
    }
    nloc = mine > 0u ? mine : 1u; nx = cnt > 0u ? cnt : 1u;
}
__device__ __forceinline__ void xcd_barrier(const XcdBarrier& b) {
    asm volatile("s_waitcnt vmcnt(0)" ::: "memory");
    __syncthreads();
    if (threadIdx.x == 0) {
        unsigned* bar = b.bar;
        __builtin_amdgcn_s_waitcnt(0);
        unsigned nloc = b.st[0], nx = b.st[1];
        if (nloc == 0u) { xcd_barrier_complete(bar, b.x, nloc, nx); b.st[0] = nloc; b.st[1] = nx; }
        const unsigned old = xb_add(&bar[XB_XSUB(b.x)], 1u);
        const unsigned gen = old / nloc;
        if (old + 1u == (gen + 1u) * nloc) {
            __builtin_amdgcn_fence(__ATOMIC_RELEASE, "agent");
            asm volatile("s_waitcnt vmcnt(0)" ::: "memory");
            const unsigned og = xb_add(&bar[XB_TOP], 1u);
            const unsigned tg = og / nx;
            if (og + 1u == (tg + 1u) * nx) xb_add(&bar[XB_TOPGEN], 1u);
            else XB_SPIN(xb_ld(&bar[XB_TOPGEN]) == tg, bar);
            __builtin_amdgcn_fence(__ATOMIC_ACQUIRE, "agent");
            xb_add(&bar[XB_XGEN(b.x)], 1u);
            asm volatile("s_waitcnt vmcnt(0)" ::: "memory");
        } else {
            XB_SPIN(xb_ld(&bar[XB_XGEN(b.x)]) == gen, bar);
            __builtin_amdgcn_fence(__ATOMIC_ACQUIRE, "agent");
            asm volatile("s_waitcnt vmcnt(0)" ::: "memory");
        }
    }
    __syncthreads();
}

struct Args { const float* in[14]; float* out; unsigned char* ws; int ph_lo, ph_hi; };
struct Frame {
    LAS unsigned char* lds;
    int tid, lane, wave, G, bid;
};
constexpr int PT_OFF = LDS_BYTES - 512;
__device__ __forceinline__ unsigned long long ptab(const Frame& F, int i) {
    volatile LAS unsigned* t = (volatile LAS unsigned*)(F.lds + PT_OFF) + 2 * i;
    const unsigned lo = __builtin_amdgcn_readfirstlane(t[0]), hi = __builtin_amdgcn_readfirstlane(t[1]);
    return ((unsigned long long)hi << 32) | lo;
}
#define INP(i) ((const float*)ptab(F, (i)))
#define OUTP() ((float*)ptab(F, 14))
#define WSB() ((unsigned char*)ptab(F, 15))
enum { I_XP = 0, I_XS = 1, I_CK = 2, I_CV = 3, I_ST = 4, I_META = 5, I_WIN = 6, I_WOUT = 7, I_NW = 8, I_FW = 9, I_SINK = 10, I_RB = 11, I_LBL = 12, I_HNW = 13 };

__device__ __forceinline__ float wave_sum(float v) {
#pragma unroll
    for (int o = 1; o < 64; o <<= 1) v += __shfl_xor(v, o);
    return v;
}

__device__ __forceinline__ int t5_bucket(int d) {
    if (d < 16) return d;
    const float v = __logf((float)d * (1.f / 16.f)) / 2.0794415416798357f * 16.f;
    int b = 16 + (int)v; return b > 31 ? 31 : b;
}

__device__ __forceinline__ void p0_transpose_item(const float* W, int K, int N, bf16_t* WT, const float* sc, LAS float* scr, int item, int lane) {
    const int nblk = N / 32, kb = item / nblk, nb = item % nblk, k0 = 64 * kb, n0 = 32 * nb;
#pragma unroll 8
    for (int i = 0; i < 32; ++i) { const int kk = 2 * i + (lane >> 5); float w = W[(size_t)(k0 + kk) * N + n0 + (lane & 31)]; if (sc) w *= sc[k0 + kk]; scr[kk * 33 + (lane & 31)] = w; }
    LDS_WAIT(); asm volatile("" ::: "memory");
    const int c = lane & 7;
#pragma unroll
    for (int j = 0; j < 4; ++j) { const int n = (lane >> 3) + 8 * j; const LAS float* s = scr + (8 * c) * 33 + n;
        u32x4 o; o.x = pk2(s[0 * 33], s[1 * 33]); o.y = pk2(s[2 * 33], s[3 * 33]); o.z = pk2(s[4 * 33], s[5 * 33]); o.w = pk2(s[6 * 33], s[7 * 33]);
        *(u32x4*)(WT + (size_t)(n0 + n) * K + k0 + 8 * c) = o; }
    LDS_WAIT(); asm volatile("" ::: "memory");
}

__device__ __forceinline__ void phase_prologue(Frame& F) {
    unsigned char* const ws = WSB(); float* const out = OUTP();
    const float* const in_w_in = INP(I_WIN); const float* const in_w_out = INP(I_WOUT); const float* const in_norm_w = INP(I_NW);
    LAS float* scr = (LAS float*)(F.lds + F.wave * 16384);
    const int gw = F.bid * NWAVES + F.wave, NGW = F.G * NWAVES;
    constexpr int I_IN = (DM / 64) * (DIN / 32), I_OUT = (DM / 64) * (DM / 32);
    constexpr int NITEMS = DEPTH * (I_IN + I_OUT);
    for (int it = gw; it < NITEMS; it += NGW) {
        if (it < DEPTH * I_IN) { const int l = it / I_IN, r = it % I_IN;
            p0_transpose_item(in_w_in + (size_t)l * DM * DIN, DM, DIN, WSP(bf16_t, WS_WIN) + (size_t)l * DIN * DM, in_norm_w + l * DM, scr, r, F.lane); }
        else { const int r2 = it - DEPTH * I_IN, l = r2 / I_OUT, r = r2 % I_OUT;
            p0_transpose_item(in_w_out + (size_t)l * DM * DM, DM, DM, WSP(bf16_t, WS_WOUT) + (size_t)l * DM * DM, nullptr, scr, r, F.lane); }
    }
    const float* const in_meta = INP(I_META); const float* const in_x_prompt = INP(I_XP); const float* const in_x_sample = INP(I_XS);
    for (int row = gw; row < MPAD; row += NGW) {
        const float* src = nullptr;
        if (row < MPR) { const int b = row / LP, t = row - b * LP; src = t < NMETA ? in_meta + (size_t)t * DM : in_x_prompt + ((size_t)b * SEQ + (t - NMETA)) * DM; }
        else if (row < MTOT) src = in_x_sample + (size_t)(row - MPR) * DM;
        float s = 0.f;
#pragma unroll
        for (int j = 0; j < 8; ++j) { const int c = (F.lane + 64 * j) * 4; f32x4 v = src ? *(const f32x4*)(src + c) : (f32x4){0.f, 0.f, 0.f, 0.f};
            *(f32x4*)(WSP(float, WS_H) + (size_t)row * DM + c) = v; u32x2 w; w.x = pk2(v[0], v[1]); w.y = pk2(v[2], v[3]); *(u32x2*)(WSP(bf16_t, WS_HB) + (size_t)row * DM + c) = w;
            s += (v[0] * v[0] + v[1] * v[1]) + (v[2] * v[2] + v[3] * v[3]); }
        s = wave_sum(s);
        if (F.lane == 0) WSP(float, WS_SSQ)[row] = s;
    }
    const int gt = F.bid * NTHR + F.tid, NGT = F.G * NTHR;
    const float* const in_lb_logits = INP(I_LBL); const float* const in_rel_bias = INP(I_RB); const float* const in_cache_k = INP(I_CK); const float* const in_cache_v = INP(I_CV);
    for (int c = gt; c < 1024; c += NGT) {
        float v[4], mx = -INFINITY;
#pragma unroll
        for (int l = 0; l < 4; ++l) { v[l] = in_lb_logits[l * 1024 + c]; mx = fmaxf(mx, v[l]); }
        float sum = 0.f;
#pragma unroll
        for (int l = 0; l < 4; ++l) { v[l] = expf(v[l] - mx); sum += v[l]; }
        float cum = 0.f; const float p0 = v[0] / sum;
#pragma unroll
        for (int l = 0; l < 4; ++l) { cum += v[l] / sum; WSP(float, WS_LB)[l * 1024 + c] = cum - p0; }
    }
    for (int i = gt; i < 16 * 128; i += NGT) { const int h = i >> 7, d = i & 127; WSP(float, WS_BIAS)[i] = in_rel_bias[t5_bucket(d) * 16 + h]; }
    { constexpr int PERLB = (WIN - DSEQ) * 256 / 4;
      constexpr int TOT = DEPTH * DBATCH * PERLB;
      for (int i = gt; i < TOT; i += NGT) { const int lbi = i / PERLB, r = i % PERLB; const size_t so = (size_t)lbi * WIN * 256 + (size_t)DSEQ * 256 + (size_t)r * 4, dofs = (size_t)lbi * WIN * 256 + (size_t)r * 4;
          *(f32x4*)(out + O_SCK + dofs) = *(const f32x4*)(in_cache_k + so); *(f32x4*)(out + O_SCV + dofs) = *(const f32x4*)(in_cache_v + so); } }
}

__device__ __forceinline__ bf16x8 ldfrag(const LAS unsigned char* base, int row, int stride_b, int kelem) { return *(const LAS bf16x8*)(base + row * stride_b + kelem * 2); }
#define MMA16(acc, nfrag, mfrag) acc = __builtin_amdgcn_mfma_f32_16x16x32_bf16(nfrag, mfrag, acc, 0, 0, 0)

constexpr int AT_QS = 0, AT_KS = 18432, AT_VT = 41472, AT_PS = 62976, AT_BT = 105984;
template <bool SAMPLE>
__device__ __forceinline__ void attn_unit(Frame& F, int l, int unit) {
    const int tid = opq(F.tid), lane = tid & 63, w = F.wave, fr = lane & 15, fq = lane >> 4;
    LAS unsigned char* lds = F.lds;
    int b, kvh, p0, nq, rowbase;
    unsigned char* const ws = WSB(); const float* const in_cache_k = INP(I_CK); const float* const in_cache_v = INP(I_CV); const float* const in_sinks = INP(I_SINK);
    constexpr int QH = SAMPLE ? 8 : 32, NR = SAMPLE ? 32 : 128;
    if (SAMPLE) { b = unit >> 2; kvh = unit & 3; p0 = 0; nq = 8; rowbase = MPR + b * DSEQ; }
    else { const int bk = unit / 65, blk = unit % 65; b = bk >> 2; kvh = bk & 3; p0 = blk * 32; nq = (LP - p0) < 32 ? (LP - p0) : 32; rowbase = b * LP; }
    const int kbase = p0 - WIN;
#pragma unroll
    for (int r = 0; r < 2; ++r) { const int q = tid + NTHR * r, row = q >> 3, c8 = q & 7; u32x4 v = (u32x4){0u, 0u, 0u, 0u};
        if (row < NR) { const int hl = row / QH, qi = row % QH; if (qi < nq) v = *(const u32x4*)(WSP(bf16_t, WS_Q) + (size_t)(rowbase + p0 + qi) * 1024 + (kvh * 4 + hl) * 64 + c8 * 8); }
        *(LAS u32x4*)(lds + AT_QS + row * 144 + c8 * 16) = v; }
#pragma unroll
    for (int r = 0; r < 3; ++r) { const int q = tid + NTHR * r; if (q < 1280) { const int j = q >> 3, c8 = q & 7, kp = kbase + j; u32x4 v = (u32x4){0u, 0u, 0u, 0u};
        if (SAMPLE) {
            if (j < WIN) { const float* src = in_cache_k + ((((size_t)l * DBATCH + b) * WIN + j) * 4 + kvh) * 64 + c8 * 8; const f32x4 a = *(const f32x4*)src, c = *(const f32x4*)(src + 4); v = pack8(a, c); }
            else if (j < WIN + DSEQ) v = *(const u32x4*)(WSP(bf16_t, WS_KB) + (size_t)(rowbase + j - WIN) * 256 + kvh * 64 + c8 * 8);
        } else { if (kp >= 0 && kp < LP) v = *(const u32x4*)(WSP(bf16_t, WS_KB) + (size_t)(rowbase + kp) * 256 + kvh * 64 + c8 * 8); }
        *(LAS u32x4*)(lds + AT_KS + j * 144 + c8 * 16) = v; } }
#pragma unroll
    for (int r = 0; r < 3; ++r) { const int q = tid + NTHR * r; if (q < 1280) { const int j = q % 160, c8 = q / 160, kp = kbase + j; u32x4 v = (u32x4){0u, 0u, 0u, 0u};
        if (SAMPLE) {
            if (j < WIN) { const float* src = in_cache_v + ((((size_t)l * DBATCH + b) * WIN + j) * 4 + kvh) * 64 + c8 * 8; const f32x4 a = *(const f32x4*)src, c = *(const f32x4*)(src + 4); v = pack8(a, c); }
            else if (j < WIN + DSEQ) v = *(const u32x4*)(WSP(bf16_t, WS_VB) + (size_t)(rowbase + j - WIN) * 256 + kvh * 64 + c8 * 8);
        } else { if (kp >= 0 && kp < LP) v = *(const u32x4*)(WSP(bf16_t, WS_VB) + (size_t)(rowbase + kp) * 256 + kvh * 64 + c8 * 8); }
        LAS unsigned short* vt = (LAS unsigned short*)(lds + AT_VT) + (c8 * 8) * 168 + j;
        vt[0 * 168] = (unsigned short)(v.x & 0xffffu); vt[1 * 168] = (unsigned short)(v.x >> 16); vt[2 * 168] = (unsigned short)(v.y & 0xffffu); vt[3 * 168] = (unsigned short)(v.y >> 16);
        vt[4 * 168] = (unsigned short)(v.z & 0xffffu); vt[5 * 168] = (unsigned short)(v.z >> 16); vt[6 * 168] = (unsigned short)(v.w & 0xffffu); vt[7 * 168] = (unsigned short)(v.w >> 16); } }
    ((LAS float*)(lds + AT_BT))[tid] = WSP(float, WS_BIAS)[(kvh * 4 + (tid >> 7)) * 128 + (tid & 127)];
    __syncthreads();
    if (w * 16 < NR) {
        f32x4 acc[10];
#pragma unroll
        for (int n = 0; n < 10; ++n) acc[n] = (f32x4){0.f, 0.f, 0.f, 0.f};
#pragma unroll
        for (int ks = 0; ks < 2; ++ks) { const bf16x8 mf = ldfrag(lds + AT_QS, w * 16 + fr, 144, ks * 32 + fq * 8);
#pragma unroll
            for (int n = 0; n < 10; ++n) { const bf16x8 nf = ldfrag(lds + AT_KS, n * 16 + fr, 144, ks * 32 + fq * 8); MMA16(acc[n], nf, mf); } }
        const int r = w * 16 + fr, hl = r / QH, qi = r % QH, p = p0 + qi;
        const bool rowok = qi < nq;
        const LAS float* bt = (const LAS float*)(lds + AT_BT) + hl * 128;
        const int kmin = SAMPLE ? -WIN : 0;
        float mx = -INFINITY;
#pragma unroll
        for (int n = 0; n < 10; ++n)
#pragma unroll
            for (int e = 0; e < 4; ++e) { const int kp = kbase + n * 16 + fq * 4 + e, dist = p - kp; const bool ok = rowok && dist >= 0 && dist < WIN && kp >= kmin;
                const float s = ok ? acc[n][e] + bt[dist & 127] : -INFINITY; acc[n][e] = s; mx = fmaxf(mx, s); }
        mx = fmaxf(mx, __shfl_xor(mx, 16)); mx = fmaxf(mx, __shfl_xor(mx, 32));
        const float sink = in_sinks[l * 16 + kvh * 4 + hl];
        const float mm = fmaxf(mx, sink);
        float sum = 0.f;
#pragma unroll
        for (int n = 0; n < 10; ++n)
#pragma unroll
            for (int e = 0; e < 4; ++e) { const float ev = __expf(acc[n][e] - mm); acc[n][e] = ev; sum += ev; }
        sum += __shfl_xor(sum, 16); sum += __shfl_xor(sum, 32);
        const float inv = 1.f / (sum + __expf(sink - mm));
#pragma unroll
        for (int n = 0; n < 10; ++n) { u32x2 pw; pw.x = pk2(acc[n][0] * inv, acc[n][1] * inv); pw.y = pk2(acc[n][2] * inv, acc[n][3] * inv);
            *(LAS u32x2*)(lds + AT_PS + r * 336 + (n * 16 + fq * 4) * 2) = pw; }
        LDS_WAIT(); asm volatile("" ::: "memory");
        f32x4 o[4];
#pragma unroll
        for (int n = 0; n < 4; ++n) o[n] = (f32x4){0.f, 0.f, 0.f, 0.f};
#pragma unroll
        for (int ks = 0; ks < 5; ++ks) { const bf16x8 mf = ldfrag(lds + AT_PS, r, 336, ks * 32 + fq * 8);
#pragma unroll
            for (int n = 0; n < 4; ++n) { const bf16x8 nf = ldfrag(lds + AT_VT, n * 16 + fr, 336, ks * 32 + fq * 8); MMA16(o[n], nf, mf); } }
        if (rowok) { const size_t grow = (size_t)(rowbase + p); const int hc = (kvh * 4 + hl) * 64;
#pragma unroll
            for (int n = 0; n < 4; ++n) { const int d = n * 16 + fq * 4; const u32x2 g = *(const u32x2*)(WSP(bf16_t, WS_GA) + grow * 1024 + hc + d);
                u32x2 yw; yw.x = pk2(o[n][0] * bflo(g.x), o[n][1] * bfhi(g.x)); yw.y = pk2(o[n][2] * bflo(g.y), o[n][3] * bfhi(g.y));
                *(u32x2*)(WSP(bf16_t, WS_Y) + grow * DM + hc + d) = yw; } }
    }
    __syncthreads();
}

constexpr int HS_F = 0, HS_K = 4096, HS_Q = 8192, HS_OP = 12288  , HS_O = 28672  ;
__device__ __forceinline__ void hgrn_sample_unit(Frame& F, int l, int unit) {
    const int tid = opq(F.tid), lane = tid & 63, w = F.wave; LAS unsigned char* lds = F.lds;
    unsigned char* const ws = WSB(); float* const out = OUTP(); const float* const in_state_h = INP(I_ST); const float* const in_hnorm_w = INP(I_HNW);
    const int b = unit >> 3, h = unit & 7, dv = tid & 127, qd = tid >> 7, rowbase = MPR + b * DSEQ;
    const size_t sbase = ((((size_t)l * DBATCH + b) * 8 + h) * 128) * 128;
    float S[32];
#pragma unroll
    for (int i = 0; i < 32; ++i) S[i] = in_state_h[sbase + (size_t)(qd * 32 + i) * 128 + dv];
#pragma unroll
    for (int r = 0; r < 2; ++r) { const int e = tid + NTHR * r, t = e >> 7, d = e & 127; const size_t o = (size_t)(rowbase + t) * 1024 + h * 128 + d;
        ((LAS float*)(lds + HS_F))[e] = __expf(WSP(float, WS_LOGF)[o]); ((LAS float*)(lds + HS_K))[e] = bf2f(WSP(bf16_t, WS_KR)[o]); ((LAS float*)(lds + HS_Q))[e] = bf2f(WSP(bf16_t, WS_QR)[o]); }
    float vv[8];
#pragma unroll
    for (int t = 0; t < 8; ++t) vv[t] = bf2f(WSP(bf16_t, WS_IR)[(size_t)(rowbase + t) * 1024 + h * 128 + dv]);
    __syncthreads();
#pragma unroll
    for (int t = 0; t < 8; ++t) { const LAS float* fp = (const LAS float*)(lds + HS_F) + t * 128 + qd * 32; const LAS float* kp = (const LAS float*)(lds + HS_K) + t * 128 + qd * 32; const LAS float* qp = (const LAS float*)(lds + HS_Q) + t * 128 + qd * 32;
        float part = 0.f;
#pragma unroll
        for (int i = 0; i < 32; ++i) { S[i] = fp[i] * S[i] + kp[i] * vv[t]; part += S[i] * qp[i]; }
        ((LAS float*)(lds + HS_OP))[(t * 4 + qd) * 128 + dv] = part; }
#pragma unroll
    for (int i = 0; i < 32; ++i) out[O_SSH + sbase + (size_t)(qd * 32 + i) * 128 + dv] = S[i];
    __syncthreads();
    { const int t = w; const LAS float* op = (const LAS float*)(lds + HS_OP) + t * 512;
      const float o0 = op[lane] + op[128 + lane] + op[256 + lane] + op[384 + lane], o1 = op[64 + lane] + op[192 + lane] + op[320 + lane] + op[448 + lane];
      const float ss = wave_sum(o0 * o0 + o1 * o1), rn = rsqrtf(ss * (1.f / 128.f) + EPS);
      const size_t row = (size_t)(rowbase + t); const int c0 = h * 128 + lane, c1 = c0 + 64;
      const float y0 = o0 * rn * in_hnorm_w[l * 1024 + c0] * bf2f(WSP(bf16_t, WS_GR)[row * 1024 + c0]), y1 = o1 * rn * in_hnorm_w[l * 1024 + c1] * bf2f(WSP(bf16_t, WS_GR)[row * 1024 + c1]);
      WSP(bf16_t, WS_Y)[row * DM + 1024 + c0] = (bf16_t)f2bf(y0); WSP(bf16_t, WS_Y)[row * DM + 1024 + c1] = (bf16_t)f2bf(y1); }
    __syncthreads();
}

constexpr int HC_A = 0, HC_ASTR = 132, HC_TOT = 33792  , HC_END = 35840;
__device__ __forceinline__ void chunk_cumsum(Frame& F, int b, int h, int c) {
    const int tid = opq(F.tid); LAS float* A = (LAS float*)(F.lds + HC_A); LAS float* TOT = (LAS float*)(F.lds + HC_TOT);
    unsigned char* const ws = WSB();
#pragma unroll
    for (int r = 0; r < 4; ++r) { const int q = tid + NTHR * r, i = q >> 5, c4 = q & 31, t = 64 * c - 48 + i; f32x4 v = (f32x4){0.f, 0.f, 0.f, 0.f};
        if (t >= 0) v = *(const f32x4*)(WSP(float, WS_LOGF) + (size_t)(b * LP + t) * 1024 + h * 128 + c4 * 4);
        *(LAS f32x4*)(A + i * HC_ASTR + c4 * 4) = v; }
    __syncthreads();
    const int d = tid & 127, sg = tid >> 7; float v[16]; float run = 0.f;
#pragma unroll
    for (int i = 0; i < 16; ++i) { run += A[(sg * 16 + i) * HC_ASTR + d]; v[i] = run; }
    TOT[sg * 128 + d] = run;
    __syncthreads();
    float off = 0.f;
#pragma unroll
    for (int s = 0; s < 3; ++s) if (s < sg) off += TOT[s * 128 + d];
#pragma unroll
    for (int i = 0; i < 16; ++i) A[(sg * 16 + i) * HC_ASTR + d] = v[i] + off;
    __syncthreads();
}
template <int MODE  >
__device__ __forceinline__ void chunk_transpose(Frame& F, const bf16_t* src, int b, int h, int c, int dst_off) {
    const int tid = opq(F.tid), i = tid & 63, t = 64 * c - 48 + i; const LAS float* A = (const LAS float*)(F.lds + HC_A);
#pragma unroll
    for (int r = 0; r < 2; ++r) { const int c8 = (tid >> 6) + 8 * r; u32x4 v = (u32x4){0u, 0u, 0u, 0u};
        if (t >= 0) v = *(const u32x4*)(src + (size_t)(b * LP + t) * 1024 + h * 128 + c8 * 8);
        float x[8] = {bflo(v.x), bfhi(v.x), bflo(v.y), bfhi(v.y), bflo(v.z), bfhi(v.z), bflo(v.w), bfhi(v.w)};
        LAS unsigned short* dst = (LAS unsigned short*)(F.lds + dst_off) + (c8 * 8) * 72 + i;
#pragma unroll
        for (int e = 0; e < 8; ++e) { float y = x[e]; if (MODE == 1) y *= __expf(A[63 * HC_ASTR + c8 * 8 + e] - A[i * HC_ASTR + c8 * 8 + e]); dst[e * 72] = (unsigned short)f2bf(y); } }
}

constexpr int HA_KT = HC_END, HA_VT = HA_KT + 18432;
__device__ __forceinline__ void hgrn_passA_unit(Frame& F, int uid) {
    unsigned char* const ws = WSB();
    const int bh = uid / NCH, c = uid % NCH, b = bh >> 3, h = bh & 7, tid = opq(F.tid), lane = tid & 63, w = F.wave, fr = lane & 15, fq = lane >> 4; LAS unsigned char* lds = F.lds;
    chunk_cumsum(F, b, h, c);
    chunk_transpose<1>(F, WSP(bf16_t, WS_KR), b, h, c, HA_KT);
    chunk_transpose<0>(F, WSP(bf16_t, WS_IR), b, h, c, HA_VT);
    if (tid < 128) WSP(float, WS_GD)[(size_t)uid * 128 + tid] = __expf(((const LAS float*)(lds + HC_A))[63 * HC_ASTR + tid]);
    __syncthreads();
    f32x4 acc[8];
#pragma unroll
    for (int n = 0; n < 8; ++n) acc[n] = (f32x4){0.f, 0.f, 0.f, 0.f};
#pragma unroll
    for (int ks = 0; ks < 2; ++ks) { const bf16x8 mf = ldfrag(lds + HA_VT, w * 16 + fr, 144, ks * 32 + fq * 8);
#pragma unroll
        for (int n = 0; n < 8; ++n) { const bf16x8 nf = ldfrag(lds + HA_KT, n * 16 + fr, 144, ks * 32 + fq * 8); MMA16(acc[n], nf, mf); } }
    float* ut = WSP(float, WS_UT) + (size_t)uid * 16384 + (size_t)(w * 16 + fr) * 128;
#pragma unroll
    for (int n = 0; n < 8; ++n) *(f32x4*)(ut + n * 16 + fq * 4) = acc[n];
    __syncthreads();
}

__device__ __forceinline__ void hgrn_scan_unit(Frame& F, int l, int unit) {
    unsigned char* const ws = WSB(); float* const out = OUTP();
    const int bh = unit >> 3, sl = unit & 7, tid = opq(F.tid), dvr = sl * 16 + (tid >> 5), dk = (tid & 31) * 4;
    f32x4 S = (f32x4){0.f, 0.f, 0.f, 0.f};
#pragma unroll 1
    for (int cb = 0; cb < NCH; cb += 11) {
        f32x4 ub[11], gb[11];
#pragma unroll
        for (int j = 0; j < 11; ++j) { const size_t uid = (size_t)bh * NCH + cb + j; ub[j] = *(const f32x4*)(WSP(float, WS_UT) + uid * 16384 + (size_t)dvr * 128 + dk); gb[j] = *(const f32x4*)(WSP(float, WS_GD) + uid * 128 + dk); }
#pragma unroll
        for (int j = 0; j < 11; ++j) { const size_t uid = (size_t)bh * NCH + cb + j; u32x2 sw; sw.x = pk2(S[0], S[1]); sw.y = pk2(S[2], S[3]);
            *(u32x2*)(WSP(bf16_t, WS_STB) + uid * 16384 + (size_t)dvr * 128 + dk) = sw; S = gb[j] * S + ub[j]; }
    }
    float* o = out + O_PSH + (((size_t)l * NBATCH * 8 + bh) * 128) * 128;
#pragma unroll
    for (int e = 0; e < 4; ++e) o[(size_t)(dk + e) * 128 + dvr] = S[e];
}

constexpr int HCc_QT = HC_END, HCc_KH = HCc_QT + 17408, HCc_VT = HCc_KH + 17408, HCc_SP = HCc_VT + 18432, HCc_PS = HCc_SP + 34816, HCc_RED = HCc_PS + 9216, HCc_END = HCc_RED + 512;
static_assert(HCc_END <= LDS_BYTES - 512, "pass C LDS");
__device__ __forceinline__ void hgrn_passC_unit(Frame& F, int l, int uid) {
    unsigned char* const ws = WSB(); const float* const in_hnorm_w = INP(I_HNW);
    const int bh = uid / NCH, c = uid % NCH, b = bh >> 3, h = bh & 7, tid = opq(F.tid), lane = tid & 63, w = F.wave, fr = lane & 15, fq = lane >> 4; LAS unsigned char* lds = F.lds;
    chunk_cumsum(F, b, h, c);
    const LAS float* A = (const LAS float*)(lds + HC_A);
#pragma unroll
    for (int r = 0; r < 2; ++r) { const int q = tid + NTHR * r, i = q >> 4, c8 = q & 15, t = 64 * c - 48 + i; u32x4 qv = (u32x4){0u, 0u, 0u, 0u}, kv = qv;
        if (t >= 0) { const size_t o = (size_t)(b * LP + t) * 1024 + h * 128 + c8 * 8; qv = *(const u32x4*)(WSP(bf16_t, WS_QR) + o); kv = *(const u32x4*)(WSP(bf16_t, WS_KR) + o); }
        const f32x4 a0 = *(const LAS f32x4*)(A + i * HC_ASTR + c8 * 8), a1 = *(const LAS f32x4*)(A + i * HC_ASTR + c8 * 8 + 4);
        const f32x4 r0 = *(const LAS f32x4*)(A + 31 * HC_ASTR + c8 * 8), r1 = *(const LAS f32x4*)(A + 31 * HC_ASTR + c8 * 8 + 4);
        f32x4 eq0, eq1, ek0, ek1;
#pragma unroll
        for (int e = 0; e < 4; ++e) { eq0[e] = __expf(a0[e] - r0[e]); eq1[e] = __expf(a1[e] - r1[e]); ek0[e] = __expf(r0[e] - a0[e]); ek1[e] = __expf(r1[e] - a1[e]); }
        const f32x4 q0 = (f32x4){bflo(qv.x), bfhi(qv.x), bflo(qv.y), bfhi(qv.y)} * eq0, q1 = (f32x4){bflo(qv.z), bfhi(qv.z), bflo(qv.w), bfhi(qv.w)} * eq1;
        const f32x4 k0 = (f32x4){bflo(kv.x), bfhi(kv.x), bflo(kv.y), bfhi(kv.y)} * ek0, k1 = (f32x4){bflo(kv.z), bfhi(kv.z), bflo(kv.w), bfhi(kv.w)} * ek1;
        *(LAS u32x4*)(lds + HCc_QT + i * 272 + c8 * 16) = pack8(q0, q1); *(LAS u32x4*)(lds + HCc_KH + i * 272 + c8 * 16) = pack8(k0, k1); }
    chunk_transpose<0>(F, WSP(bf16_t, WS_IR), b, h, c, HCc_VT);
#pragma unroll
    for (int r = 0; r < 4; ++r) { const int q = tid + NTHR * r, dvr = q >> 4, c8 = q & 15; const u32x4 sv = *(const u32x4*)(WSP(bf16_t, WS_STB) + (size_t)uid * 16384 + (size_t)dvr * 128 + c8 * 8);
        const f32x4 r0 = *(const LAS f32x4*)(A + 31 * HC_ASTR + c8 * 8), r1 = *(const LAS f32x4*)(A + 31 * HC_ASTR + c8 * 8 + 4);
        f32x4 s0 = (f32x4){bflo(sv.x), bfhi(sv.x), bflo(sv.y), bfhi(sv.y)}, s1 = (f32x4){bflo(sv.z), bfhi(sv.z), bflo(sv.w), bfhi(sv.w)};
#pragma unroll
        for (int e = 0; e < 4; ++e) { s0[e] *= __expf(r0[e]); s1[e] *= __expf(r1[e]); }
        *(LAS u32x4*)(lds + HCc_SP + dvr * 272 + c8 * 16) = pack8(s0, s1); }
    __syncthreads();
    { const int mt = w >> 1;
      f32x4 p[2];
#pragma unroll
      for (int j = 0; j < 2; ++j) p[j] = (f32x4){0.f, 0.f, 0.f, 0.f};
#pragma unroll
      for (int ks = 0; ks < 4; ++ks) { const bf16x8 mf = ldfrag(lds + HCc_QT, mt * 16 + fr, 272, ks * 32 + fq * 8);
#pragma unroll
          for (int j = 0; j < 2; ++j) { const int nt = (w & 1) * 2 + j; const bf16x8 nf = ldfrag(lds + HCc_KH, nt * 16 + fr, 272, ks * 32 + fq * 8); MMA16(p[j], nf, mf); } }
#pragma unroll
      for (int j = 0; j < 2; ++j) { const int nt = (w & 1) * 2 + j, ti = mt * 16 + fr, s0 = nt * 16 + fq * 4; float pv[4];
#pragma unroll
          for (int e = 0; e < 4; ++e) pv[e] = (s0 + e <= ti) ? p[j][e] : 0.f;
          u32x2 pw; pw.x = pk2(pv[0], pv[1]); pw.y = pk2(pv[2], pv[3]); *(LAS u32x2*)(lds + HCc_PS + ti * 144 + s0 * 2) = pw; } }
    __syncthreads();
    { const int mt = w & 3, nb = (w >> 2) * 4; f32x4 o[4];
#pragma unroll
      for (int n = 0; n < 4; ++n) o[n] = (f32x4){0.f, 0.f, 0.f, 0.f};
#pragma unroll
      for (int ks = 0; ks < 2; ++ks) { const bf16x8 mf = ldfrag(lds + HCc_PS, mt * 16 + fr, 144, ks * 32 + fq * 8);
#pragma unroll
          for (int n = 0; n < 4; ++n) { const bf16x8 nf = ldfrag(lds + HCc_VT, (nb + n) * 16 + fr, 144, ks * 32 + fq * 8); MMA16(o[n], nf, mf); } }
#pragma unroll
      for (int ks = 0; ks < 4; ++ks) { const bf16x8 mf = ldfrag(lds + HCc_QT, mt * 16 + fr, 272, ks * 32 + fq * 8);
#pragma unroll
          for (int n = 0; n < 4; ++n) { const bf16x8 nf = ldfrag(lds + HCc_SP, (nb + n) * 16 + fr, 272, ks * 32 + fq * 8); MMA16(o[n], nf, mf); } }
      float ss = 0.f;
#pragma unroll
      for (int n = 0; n < 4; ++n) ss += (o[n][0] * o[n][0] + o[n][1] * o[n][1]) + (o[n][2] * o[n][2] + o[n][3] * o[n][3]);
      ss += __shfl_xor(ss, 16); ss += __shfl_xor(ss, 32);
      const int ti = mt * 16 + fr;
      if (fq == 0) ((LAS float*)(lds + HCc_RED))[(w >> 2) * 64 + ti] = ss;
      __syncthreads();
      const float tot = ((const LAS float*)(lds + HCc_RED))[ti] + ((const LAS float*)(lds + HCc_RED))[64 + ti];
      const float rn = rsqrtf(tot * (1.f / 128.f) + EPS);
      const int t = 64 * c - 48 + ti;
      if (t >= 0) { const size_t row = (size_t)(b * LP + t);
#pragma unroll
          for (int n = 0; n < 4; ++n) { const int col = h * 128 + (nb + n) * 16 + fq * 4; const f32x4 nw = *(const f32x4*)(in_hnorm_w + l * 1024 + col); const u32x2 g = *(const u32x2*)(WSP(bf16_t, WS_GR) + row * 1024 + col);
              u32x2 yw; yw.x = pk2(o[n][0] * rn * nw[0] * bflo(g.x), o[n][1] * rn * nw[1] * bfhi(g.x)); yw.y = pk2(o[n][2] * rn * nw[2] * bflo(g.y), o[n][3] * rn * nw[3] * bfhi(g.y));
              *(u32x2*)(WSP(bf16_t, WS_Y) + row * DM + 1024 + col) = yw; } } }
    __syncthreads();
}

__device__ __forceinline__ void phase_final(Frame& F) {
    unsigned char* const ws = WSB(); float* const out = OUTP(); const float* const in_final_w = INP(I_FW);
    const int gw = F.bid * NWAVES + F.wave, NGW = F.G * NWAVES; const float* ssq = WSP(float, WS_SSQ) + 4 * MPAD;
    for (int i = gw; i < NBATCH * SEQ + MSA; i += NGW) {
        int row; float* dst;
        if (i < NBATCH * SEQ) { const int b = i / SEQ, s = i % SEQ; row = b * LP + NMETA + s; dst = out + O_YP + (size_t)i * DM; }
        else { row = MPR + (i - NBATCH * SEQ); dst = out + O_YS + (size_t)(i - NBATCH * SEQ) * DM; }
        const float rs = rsqrtf(ssq[row] * (1.f / 2048.f) + EPS);
#pragma unroll
        for (int j = 0; j < 8; ++j) { const int c = (F.lane + 64 * j) * 4; const f32x4 v = *(const f32x4*)(WSP(float, WS_H) + (size_t)row * DM + c), wv = *(const f32x4*)(in_final_w + c); *(f32x4*)(dst + c) = v * rs * wv; }
    }
}

constexpr int NPHASE = 22;
constexpr int NMIXA = NUNIT + 4 * 4 * 65 + DBATCH * 4 + DBATCH * 8;

#ifndef EN_PRO
#define EN_PRO 1
#endif
#ifndef EN_GIN
#define EN_GIN 1
#endif
#ifndef EN_GOUT
#define EN_GOUT 1
#endif
#ifndef EN_PA
#define EN_PA 1
#endif
#ifndef EN_ATT
#define EN_ATT 1
#endif
#ifndef EN_HS
#define EN_HS 1
#endif
#ifndef EN_SCAN
#define EN_SCAN 1
#endif
#ifndef EN_PC
#define EN_PC 1
#endif
#ifndef EN_FIN
#define EN_FIN 1
#endif
__global__ void __launch_bounds__(NTHR, 2) hymba_fwd(Args args) {
    extern __shared__ __attribute__((aligned(16))) unsigned char lds_raw[];
    Frame F;
    F.lds = (LAS unsigned char*)lds_raw;
    F.tid = threadIdx.x; F.lane = F.tid & 63; F.wave = __builtin_amdgcn_readfirstlane(F.tid >> 6); F.G = gridDim.x; F.bid = blockIdx.x;
    volatile LAS unsigned* MISC = (volatile LAS unsigned*)(F.lds + MISC_OFF);
    if (F.tid < 32) MISC[F.tid] = 0u;
    if (F.tid == 0) { LAS unsigned long long* pt = (LAS unsigned long long*)(F.lds + PT_OFF);
#pragma unroll
        for (int i = 0; i < 14; ++i) pt[i] = (unsigned long long)args.in[i];
        pt[14] = (unsigned long long)args.out; pt[15] = (unsigned long long)args.ws; }
    __syncthreads();
    const int lo = args.ph_lo, hi = args.ph_hi;
    XcdBarrier bar; bar.bar = nullptr; bar.x = 0; bar.st = nullptr;
    if ((hi - lo) > 1) bar = xcd_barrier_post((unsigned*)WSB() + CW_BAR, MISC + 8);
#define IN(k) (lo <= (k) && (k) < hi)
#define SEAM(k) do { if (IN(k) && IN((k) + 1)) xcd_barrier(bar); } while (0)

    if (EN_PRO && IN(0)) { phase_prologue(F); }
    SEAM(0);
#pragma unroll 1
    for (int l = 0; l < DEPTH; ++l) {
        const int pb = 1 + 5 * l;
        if (EN_GIN && IN(pb)) {
            unsigned char* const ws = WSB();
            pg8::Gemm g{WSP(bf16_t, WS_HB), WSP(bf16_t, WS_WIN) + (size_t)l * DIN * DM, MPAD, DIN, DM}; pg8::StaticOrder S; S.init(MPAD, DIN, F.G, F.bid);
            EpiIn E; E.ws = ws; E.out = OUTP(); E.l = l;
            pg8::gemm_phase<EpiIn, pg8::StaticOrder>(F.lds, g, S, E);
        }
        SEAM(pb);
        if (IN(pb + 1)) {
            if (EN_PA) {
#pragma unroll 1
                for (int i = F.bid; i < NUNIT; i += F.G) hgrn_passA_unit(F, i); }
            if (EN_ATT) {
#pragma unroll 1
                for (int i = (F.bid + 224) % F.G; i < 1040; i += F.G) attn_unit<false>(F, l, i); }
            if (EN_ATT) {
#pragma unroll 1
                for (int i = (F.bid + 192) % F.G; i < 128; i += F.G) attn_unit<true>(F, l, i); }
            if (EN_HS) {
#pragma unroll 1
                for (int i = F.bid; i < 256; i += F.G) hgrn_sample_unit(F, l, i); }
        }
        SEAM(pb + 1);
        if (EN_SCAN && IN(pb + 2)) {
#pragma unroll 1
            for (int i = F.bid; i < 256; i += F.G) hgrn_scan_unit(F, l, i);
        }
        SEAM(pb + 2);
        if (EN_PC && IN(pb + 3)) {
#pragma unroll 1
            for (int i = F.bid; i < NUNIT; i += F.G) hgrn_passC_unit(F, l, i);
        }
        SEAM(pb + 3);
        if (EN_GOUT && IN(pb + 4)) {
            unsigned char* const ws = WSB();
            pg8::Gemm g{WSP(bf16_t, WS_Y), WSP(bf16_t, WS_WOUT) + (size_t)l * DM * DM, MPAD, DM, DM}; pg8::StaticOrder S; S.init(MPAD, DM, F.G, F.bid);
            EpiOut E; E.ws = ws; E.l = l;
            pg8::gemm_phase<EpiOut, pg8::StaticOrder>(F.lds, g, S, E);
        }
        SEAM(pb + 4);
    }
    if (EN_FIN && IN(21)) phase_final(F);
#undef IN
#undef SEAM
}

extern "C" void kernel_launch(void* const* d_in, const int* in_sizes, int n_in, void* d_out, int out_size, void* d_ws, size_t ws_size, hipStream_t stream) {
    static int grid = 0;
    if (grid == 0) {
        if (n_in != 14 || ws_size < WS_END) { fprintf(stderr, "kernel_launch: unexpected problem (n_in %d, ws %zu < %zu)\n", n_in, ws_size, (size_t)WS_END); grid = -1; return; }
        int dev = 0, cus = 0, per_cu = 0;
        if (hipGetDevice(&dev) != hipSuccess || hipDeviceGetAttribute(&cus, hipDeviceAttributeMultiprocessorCount, dev) != hipSuccess) { grid = -1; return; }
        if (hipFuncSetAttribute((const void*)hymba_fwd, hipFuncAttributeMaxDynamicSharedMemorySize, LDS_BYTES) != hipSuccess) { fprintf(stderr, "kernel_launch: hipFuncSetAttribute failed\n"); grid = -1; return; }
        if (hipOccupancyMaxActiveBlocksPerMultiprocessor(&per_cu, (const void*)hymba_fwd, NTHR, LDS_BYTES) != hipSuccess || per_cu < 1) { fprintf(stderr, "kernel_launch: occupancy query says %d blocks per CU\n", per_cu); (void)hipGetLastError(); grid = -1; return; }
        grid = cus;
    }
    if (grid < 0) return;
    (void)hipMemsetAsync((char*)d_ws + WS_CTL, 0, CTL_ZERO_BYTES, stream);
    Args a{};
    for (int i = 0; i < 14; ++i) a.in[i] = (const float*)d_in[i];
    a.out = (float*)d_out; a.ws = (unsigned char*)d_ws;
#if MK_SINGLE
    a.ph_lo = 0; a.ph_hi = NPHASE;
    void* kargs[] = {&a};
    hipError_t e = hipLaunchCooperativeKernel((const void*)hymba_fwd, dim3(grid), dim3(NTHR), kargs, LDS_BYTES, stream);
    if (e != hipSuccess) fprintf(stderr, "kernel_launch: cooperative launch failed: %s (grid %d)\n", hipGetErrorString(e), grid);
#else
    for (int p = 0; p < NPHASE; ++p) { a.ph_lo = p; a.ph_hi = p + 1; hipLaunchKernelGGL(hymba_fwd, dim3(grid), dim3(NTHR), LDS_BYTES, stream, a); }
#endif
}
```

```cpp
#include <hip/hip_runtime.h>
#include <cstdio>
#include <cstdint>

#ifndef MK_SINGLE
#define MK_SINGLE 1
#endif

#define LAS __attribute__((address_space(3)))
typedef unsigned short bf16_t;
typedef short bf16x8 __attribute__((ext_vector_type(8)));
typedef float f32x4 __attribute__((ext_vector_type(4)));
typedef float f32x2 __attribute__((ext_vector_type(2)));
typedef unsigned u32x4 __attribute__((ext_vector_type(4)));
typedef unsigned u32x2 __attribute__((ext_vector_type(2)));

constexpr int DM = 2048, NBATCH = 4, SEQ = 2048, NMETA = 16, LP = SEQ + NMETA;
constexpr int MPR = NBATCH * LP;
constexpr int DBATCH = 32, DSEQ = 8, MSA = DBATCH * DSEQ;
constexpr int MTOT = MPR + MSA;
constexpr int MPAD = 8704;
constexpr int DIN = 6656, DEPTH = 4, WIN = 128;
constexpr int NCH = 33;
constexpr int NUNIT = NBATCH * 8 * NCH;
constexpr float EPS = 1e-6f;

constexpr size_t O_YP = 0, O_YS = 16777216, O_PCK = 17301504, O_PCV = 17825792, O_PSH = 18350080, O_SCK = 20447232, O_SCV = 24641536, O_SSH = 28835840;

constexpr size_t MiB = 1u << 20;
constexpr size_t WS_CTL = 0, CTL_ZERO_BYTES = 1 * MiB;
constexpr size_t WS_SSQ = 512 * 1024;
constexpr size_t WS_LB = 1 * MiB;
constexpr size_t WS_BIAS = WS_LB + 16384;
constexpr size_t WS_WIN = 2 * MiB;
constexpr size_t WS_WOUT = WS_WIN + (size_t)DEPTH * DIN * DM * 2;
constexpr size_t WS_H = WS_WOUT + (size_t)DEPTH * DM * DM * 2;
constexpr size_t WS_HB = WS_H + (size_t)MPAD * DM * 4;
constexpr size_t WS_Q = WS_HB + (size_t)MPAD * DM * 2;
constexpr size_t SZ1K = (size_t)MPAD * 1024 * 2;
constexpr size_t WS_GA = WS_Q + SZ1K, WS_QR = WS_GA + SZ1K, WS_KR = WS_QR + SZ1K, WS_IR = WS_KR + SZ1K, WS_GR = WS_IR + SZ1K;
constexpr size_t WS_KB = WS_GR + SZ1K;
constexpr size_t WS_VB = WS_KB + (size_t)MPAD * 256 * 2;
constexpr size_t WS_LOGF = WS_VB + (size_t)MPAD * 256 * 2;
constexpr size_t WS_Y = WS_LOGF + (size_t)MPAD * 1024 * 4;
constexpr size_t WS_UT = WS_Y + (size_t)MPAD * DM * 2;
constexpr size_t WS_GD = WS_UT + (size_t)NUNIT * 16384 * 4;
constexpr size_t WS_STB = WS_GD + (size_t)NUNIT * 128 * 4;
constexpr size_t WS_END = WS_STB + (size_t)NUNIT * 16384 * 2;
constexpr int CW_BAR = 4096;

constexpr int NWAVES = 8, NTHR = 512;
constexpr int LDS_BYTES = 147456;
constexpr int RING_BYTES = 131072;
constexpr int MISC_OFF = LDS_BYTES - 256;

#define WSP(T, off) ((T*)(ws + (off)))
#define LDS_WAIT() asm volatile("s_waitcnt lgkmcnt(0)" ::: "memory")
#define VM_WAIT() asm volatile("s_waitcnt vmcnt(0)" ::: "memory")

__device__ __forceinline__ unsigned f2bf(float f) { unsigned u = __builtin_bit_cast(unsigned, f); return (u + 0x7fffu + ((u >> 16) & 1u)) >> 16; }
__device__ __forceinline__ unsigned pk2(float lo, float hi) { return f2bf(lo) | (f2bf(hi) << 16); }
__device__ __forceinline__ float bf2f(unsigned short b) { return __builtin_bit_cast(float, (unsigned)b << 16); }
__device__ __forceinline__ float bflo(unsigned w) { return __builtin_bit_cast(float, w << 16); }
__device__ __forceinline__ float bfhi(unsigned w) { return __builtin_bit_cast(float, w & 0xffff0000u); }
__device__ __forceinline__ int opq(int x) { asm volatile("" : "+v"(x)); return x; }
__device__ __forceinline__ float silu_f(float x) { return x * __frcp_rn(1.f + __expf(-x)); }

namespace pg8 {
constexpr int BM = 256, BK = 64, HALF = 128, HTB = HALF * BK * 2, STAGE_BYTES = 8 * HTB, NXCD = 8, WGM = 8;
__host__ __device__ __forceinline__ int lds_byte(int r, int c) { const int st = (r >> 4) * 2 + (c >> 5), rr = r & 15, cc = c & 31, ob = rr * 64 + cc * 2; return st * 1024 + (ob ^ (((ob >> 9) & 1) << 5)); }
__host__ __device__ __forceinline__ void stage_rc(int b, int& R, int& C) { const int st = b / 1024, sb = b % 1024, swz = sb ^ (((sb >> 9) & 1) << 5); R = (st >> 1) * 16 + swz / 64; C = (st & 1) * 32 + (swz % 64) / 2; }
__host__ __device__ __forceinline__ int perm32(int rho) { const int n = rho >> 4, i = rho & 15; return 8 * (i >> 2) + 4 * n + (i & 3); }

struct Unit { int pm, pn; };
struct Gemm { const bf16_t* A; const bf16_t* Bt; int M, N, K; };

struct StaticOrder {
    int nM, nN, nwg, G, c;
    __host__ __device__ void init(int M, int N, int G_, int c_) { nM = M / BM; nN = N / BM; nwg = nM * nN; G = G_; c = c_; }
    __host__ __device__ bool next(int i, Unit& u) const {
        const long L = (long)i * G + c; if (L >= nwg) return false;
        int wgid = (int)L; { const int q = nwg / NXCD, r = nwg % NXCD, xcd = wgid % NXCD, off = wgid / NXCD; wgid = (xcd < r ? xcd * (q + 1) : r * (q + 1) + (xcd - r) * q) + off; }
        const int nig = WGM * nN, gid = wgid / nig, fm = gid * WGM, gsz = (nM - fm) < WGM ? (nM - fm) : WGM;
        u.pm = fm + ((wgid % nig) % gsz); u.pn = (wgid % nig) / gsz; return true;
    }
    __device__ __forceinline__ void a_ready(const Unit&) const {}
    __device__ __forceinline__ void done(const Unit&) const {}
};

template <class Epi, class Sched>
__device__ __forceinline__ void gemm_phase(LAS unsigned char* lds, const Gemm g, const Sched& S, const Epi& E) {
    const int tid = opq((int)threadIdx.x), wid = __builtin_amdgcn_readfirstlane(tid >> 6), lane = tid & 63, wr = wid >> 2, wc = wid & 3, fr = lane & 15, fq = lane >> 4;
    const int K = g.K, nt = K / BK;
    unsigned voffA[2], voffB[2];
#pragma unroll
    for (int i = 0; i < 2; ++i) { int R, C; stage_rc(tid * 16 + i * 8192, R, C); const int Rb = Epi::PERM ? ((R & ~31) + perm32(R & 31)) : R;
        voffA[i] = (unsigned)(R * K + C) * 2u; voffB[i] = (unsigned)(Rb * K + C) * 2u; }
    const size_t kstep = (size_t)(BK * 2);
    const size_t hstep = (size_t)HALF * K * 2;
    const size_t tstep = 2 * hstep;
    const unsigned ldsw = (unsigned)wid * 1024u;
    const int aoff = lds_byte(wr * 64 + fr, fq * 8), boff = lds_byte(wc * 32 + fr, fq * 8);
#define PG8_SA(b, h) (((b) * 2 + (h)) * HTB)
#define PG8_SB(b, h) ((4 + (b) * 2 + (h)) * HTB)
#define PG8_STAGE(bufoff, gbase, voff) do { _Pragma("unroll") for (int _i = 0; _i < 2; ++_i) \
        __builtin_amdgcn_global_load_lds((const unsigned*)((const char*)(gbase) + (voff)[_i]), (LAS unsigned*)(lds + (bufoff) + ldsw + _i * 8192), 16, 0, 0); } while (0)
#define PG8_LDA(dst, b, h) do { _Pragma("unroll") for (int m = 0; m < 4; ++m) _Pragma("unroll") for (int k = 0; k < 2; ++k) dst[m][k] = *(const LAS bf16x8*)(lds + PG8_SA(b, h) + aoff + m * 2048 + k * 1024); } while (0)
#define PG8_LDB(dst, b, h) do { _Pragma("unroll") for (int n = 0; n < 2; ++n) _Pragma("unroll") for (int k = 0; k < 2; ++k) dst[n][k] = *(const LAS bf16x8*)(lds + PG8_SB(b, h) + boff + n * 2048 + k * 1024); } while (0)
#define PG8_MMA(ai, bj, At, Bt) do { __builtin_amdgcn_s_setprio(1); _Pragma("unroll") for (int m = 0; m < 4; ++m) _Pragma("unroll") for (int n = 0; n < 2; ++n) _Pragma("unroll") for (int k = 0; k < 2; ++k) \
        acc[ai][bj][m][n] = __builtin_amdgcn_mfma_f32_16x16x32_bf16(Bt[n][k], At[m][k], acc[ai][bj][m][n], 0, 0, 0); __builtin_amdgcn_s_setprio(0); } while (0)
#define PG8_WAIT_V(n) asm volatile("s_waitcnt vmcnt(" #n ")" ::: "memory")
#define PG8_WAIT_L(n) asm volatile("s_waitcnt lgkmcnt(" #n ")" ::: "memory")
#define PG8_BAR __builtin_amdgcn_s_barrier()
#define PG8_SCHED __builtin_amdgcn_sched_barrier(0)
    Unit cur, nxt; int ui = 0;
    if (!S.next(0, cur)) return;
    f32x4 acc[2][2][4][2];
#pragma unroll
    for (int a = 0; a < 2; ++a)
#pragma unroll
        for (int b = 0; b < 2; ++b)
#pragma unroll
            for (int m = 0; m < 4; ++m)
#pragma unroll
                for (int n = 0; n < 2; ++n) acc[a][b][m][n] = (f32x4){0.f, 0.f, 0.f, 0.f};
    bf16x8 At[4][2], B0[2][2], B1[2][2];
    const char* cA = (const char*)g.A + (size_t)cur.pm * tstep; const char* cB = (const char*)g.Bt + (size_t)cur.pn * tstep;
    S.a_ready(cur);
    PG8_STAGE(PG8_SB(0, 0), cB, voffB); PG8_STAGE(PG8_SB(0, 1), cB + hstep, voffB); PG8_STAGE(PG8_SA(0, 0), cA, voffA); PG8_STAGE(PG8_SA(0, 1), cA + hstep, voffA);
    if (wr == 1) PG8_BAR;
    PG8_WAIT_V(2); PG8_BAR;
    PG8_STAGE(PG8_SB(1, 0), cB + kstep, voffB); PG8_STAGE(PG8_SA(1, 0), cA + kstep, voffA); PG8_STAGE(PG8_SB(1, 1), cB + hstep + kstep, voffB);
    PG8_WAIT_V(6); PG8_BAR;
    for (;;) {
        const bool has_next = S.next(ui + 1, nxt);
        const char* nA = has_next ? (const char*)g.A + (size_t)nxt.pm * tstep : cA; const char* nB = has_next ? (const char*)g.Bt + (size_t)nxt.pn * tstep : cB;
        for (int t = 0; t < nt; t += 2) {
            const bool last = (t == nt - 2);
            const char* a1 = cA + (size_t)(t + 1) * kstep;
            const char* a2 = last ? nA : cA + (size_t)(t + 2) * kstep; const char* b2 = last ? nB : cB + (size_t)(t + 2) * kstep;
            const char* a3 = a2 + kstep; const char* b3 = b2 + kstep;
            if (last && has_next) S.a_ready(nxt);
            PG8_LDB(B0, 0, 0); PG8_LDB(B1, 0, 1); PG8_SCHED; PG8_LDA(At, 0, 0); PG8_STAGE(PG8_SA(1, 1), a1 + hstep, voffA);
            PG8_WAIT_V(8); PG8_WAIT_L(0); PG8_BAR; PG8_MMA(0, 0, At, B0); PG8_MMA(0, 1, At, B1); PG8_BAR; PG8_SCHED;
            PG8_LDA(At, 0, 1); PG8_STAGE(PG8_SB(0, 0), b2, voffB); PG8_STAGE(PG8_SB(0, 1), b2 + hstep, voffB); PG8_STAGE(PG8_SA(0, 0), a2, voffA);
            PG8_WAIT_V(8); PG8_WAIT_L(0); PG8_BAR; PG8_MMA(1, 0, At, B0); PG8_MMA(1, 1, At, B1); PG8_BAR; PG8_SCHED;
            PG8_LDB(B0, 1, 0); PG8_LDB(B1, 1, 1); PG8_SCHED; PG8_LDA(At, 1, 0); PG8_STAGE(PG8_SA(0, 1), a2 + hstep, voffA);
            PG8_WAIT_V(8); PG8_WAIT_L(0); PG8_BAR; PG8_MMA(0, 0, At, B0); PG8_MMA(0, 1, At, B1); PG8_BAR; PG8_SCHED;
            PG8_LDA(At, 1, 1); PG8_STAGE(PG8_SB(1, 0), b3, voffB); PG8_STAGE(PG8_SB(1, 1), b3 + hstep, voffB); PG8_STAGE(PG8_SA(1, 0), a3, voffA);
            PG8_WAIT_V(8); PG8_WAIT_L(0); PG8_BAR; PG8_MMA(1, 0, At, B0); PG8_MMA(1, 1, At, B1); PG8_BAR; PG8_SCHED;
        }
        if (wr == 0) PG8_BAR;
        E(acc, cur, wr, wc, fr, fq); S.done(cur);
        if (!has_next) break;
#pragma unroll
        for (int a = 0; a < 2; ++a)
#pragma unroll
            for (int b = 0; b < 2; ++b)
#pragma unroll
                for (int m = 0; m < 4; ++m)
#pragma unroll
                    for (int n = 0; n < 2; ++n) acc[a][b][m][n] = (f32x4){0.f, 0.f, 0.f, 0.f};
        cur = nxt; cA = nA; cB = nB; ++ui;
        if (wr == 1) PG8_BAR;
    }
    PG8_WAIT_V(0);
    PG8_BAR;
#undef PG8_SA
#undef PG8_SB
#undef PG8_STAGE
#undef PG8_LDA
#undef PG8_LDB
#undef PG8_MMA
#undef PG8_WAIT_V
#undef PG8_WAIT_L
#undef PG8_BAR
#undef PG8_SCHED
}
}

__device__ __forceinline__ u32x4 pack8(const f32x4 a, const f32x4 b) { u32x4 w; w.x = pk2(a[0], a[1]); w.y = pk2(a[2], a[3]); w.z = pk2(b[0], b[1]); w.w = pk2(b[2], b[3]); return w; }

struct EpiIn {
    static constexpr bool PERM = true;
    unsigned char* ws; float* out; int l;
    __device__ __forceinline__ void operator()(const f32x4 (&acc)[2][2][4][2], const pg8::Unit& u, int wr, int wc, int fr, int fq) const {
        const int pn = u.pn, row0 = u.pm * 256 + wr * 64 + fr, cw = wc * 32 + 8 * fq;
        const float* const ssq = WSP(const float, WS_SSQ) + l * MPAD;
        if (pn < 4 || (pn >= 6 && pn < 14) || pn >= 18) {
            bf16_t* base; int mode; int cb;
            if (pn < 4) { base = WSP(bf16_t, WS_Q); mode = 0; cb = pn * 256; }
            else if (pn < 10) { base = WSP(bf16_t, WS_GA); mode = 1; cb = (pn - 6) * 256; }
            else if (pn < 14) { base = WSP(bf16_t, WS_QR); mode = 1; cb = (pn - 10) * 256; }
            else if (pn < 22) { base = WSP(bf16_t, WS_IR); mode = 2; cb = (pn - 18) * 256; }
            else { base = WSP(bf16_t, WS_GR); mode = 1; cb = (pn - 22) * 256; }
#pragma unroll
            for (int ai = 0; ai < 2; ++ai)
#pragma unroll
                for (int m = 0; m < 4; ++m) { const int row = row0 + ai * 128 + m * 16; const float rs = rsqrtf(ssq[row] * (1.f / 2048.f) + EPS);
#pragma unroll
                    for (int bj = 0; bj < 2; ++bj) { f32x4 v0 = acc[ai][bj][m][0] * rs, v1 = acc[ai][bj][m][1] * rs;
                        if (mode == 0) { v0 = v0 * 0.125f; v1 = v1 * 0.125f; }
                        else if (mode == 1) {
#pragma unroll
                            for (int e = 0; e < 4; ++e) { v0[e] = silu_f(v0[e]); v1[e] = silu_f(v1[e]); } }
                        *(u32x4*)(base + (size_t)row * 1024 + cb + cw + bj * 128) = pack8(v0, v1); } }
        } else if (pn < 6) {
            bf16_t* base = pn == 4 ? WSP(bf16_t, WS_KB) : WSP(bf16_t, WS_VB); float* pc = out + (pn == 4 ? O_PCK : O_PCV) + (size_t)l * NBATCH * WIN * 256; float* sc = out + (pn == 4 ? O_SCK : O_SCV) + (size_t)l * DBATCH * WIN * 256;
#pragma unroll
            for (int ai = 0; ai < 2; ++ai)
#pragma unroll
                for (int m = 0; m < 4; ++m) { const int row = row0 + ai * 128 + m * 16; const float rs = rsqrtf(ssq[row] * (1.f / 2048.f) + EPS);
                    float* dst = nullptr;
                    if (row < MPR) { const int b = row / LP, t = row - b * LP; if (t >= LP - WIN) dst = pc + ((size_t)(b * WIN + t - (LP - WIN))) * 256; }
                    else if (row < MTOT) { const int rr = row - MPR; dst = sc + ((size_t)((rr >> 3) * WIN + (WIN - DSEQ) + (rr & 7))) * 256; }
#pragma unroll
                    for (int bj = 0; bj < 2; ++bj) { const f32x4 v0 = acc[ai][bj][m][0] * rs, v1 = acc[ai][bj][m][1] * rs; const int c = cw + bj * 128;
                        *(u32x4*)(base + (size_t)row * 256 + c) = pack8(v0, v1);
                        if (dst) { *(f32x4*)(dst + c) = v0; *(f32x4*)(dst + c + 4) = v1; } } }
        } else {
            const int cb = (pn - 14) * 256; const float* const lb = WSP(const float, WS_LB) + l * 1024; float* const LOGF = WSP(float, WS_LOGF); bf16_t* const KR = WSP(bf16_t, WS_KR);
            f32x4 l0[2], l1[2];
#pragma unroll
            for (int bj = 0; bj < 2; ++bj) { l0[bj] = *(const f32x4*)(lb + cb + cw + bj * 128); l1[bj] = *(const f32x4*)(lb + cb + cw + bj * 128 + 4); }
#pragma unroll
            for (int ai = 0; ai < 2; ++ai)
#pragma unroll
                for (int m = 0; m < 4; ++m) { const int row = row0 + ai * 128 + m * 16; const float rs = rsqrtf(ssq[row] * (1.f / 2048.f) + EPS);
#pragma unroll
                    for (int bj = 0; bj < 2; ++bj) { const f32x4 x0 = acc[ai][bj][m][0] * rs, x1 = acc[ai][bj][m][1] * rs; f32x4 f0, f1, k0, k1;
#pragma unroll
                        for (int e = 0; e < 4; ++e) {
                            { const float x = x0[e], lbv = l0[bj][e], sp = __frcp_rn(1.f + __expf(-x)), sn = __frcp_rn(1.f + __expf(x)); f0[e] = fmaxf(__logf(lbv + (1.f - lbv) * sp), -80.f); k0[e] = (1.f - lbv) * sn; }
                            { const float x = x1[e], lbv = l1[bj][e], sp = __frcp_rn(1.f + __expf(-x)), sn = __frcp_rn(1.f + __expf(x)); f1[e] = fmaxf(__logf(lbv + (1.f - lbv) * sp), -80.f); k1[e] = (1.f - lbv) * sn; } }
                        const size_t o = (size_t)row * 1024 + cb + cw + bj * 128;
                        *(f32x4*)(LOGF + o) = f0; *(f32x4*)(LOGF + o + 4) = f1; *(u32x4*)(KR + o) = pack8(k0, k1); } }
        }
    }
};

struct EpiOut {
    static constexpr bool PERM = true;
    unsigned char* ws; int l;
    __device__ __forceinline__ void operator()(const f32x4 (&acc)[2][2][4][2], const pg8::Unit& u, int wr, int wc, int fr, int fq) const {
        const int row0 = u.pm * 256 + wr * 64 + fr, c0 = u.pn * 256 + wc * 32 + 8 * fq;
        bf16_t* const HB = WSP(bf16_t, WS_HB); float* const ssq_next = WSP(float, WS_SSQ) + (l + 1) * MPAD;
#pragma unroll
        for (int ai = 0; ai < 2; ++ai)
#pragma unroll
            for (int m = 0; m < 4; ++m) { const int row = row0 + ai * 128 + m * 16; float s = 0.f;
#pragma unroll
                for (int bj = 0; bj < 2; ++bj) { bf16_t* hp = HB + (size_t)row * DM + c0 + bj * 128; const u32x4 hv = *(const u32x4*)hp;
                    const f32x4 h0 = (f32x4){bflo(hv.x), bfhi(hv.x), bflo(hv.y), bfhi(hv.y)} + acc[ai][bj][m][0], h1 = (f32x4){bflo(hv.z), bfhi(hv.z), bflo(hv.w), bfhi(hv.w)} + acc[ai][bj][m][1];
                    *(u32x4*)hp = pack8(h0, h1);
                    s += (h0[0] * h0[0] + h0[1] * h0[1]) + (h0[2] * h0[2] + h0[3] * h0[3]) + (h1[0] * h1[0] + h1[1] * h1[1]) + (h1[2] * h1[2] + h1[3] * h1[3]); }
                s += __shfl_xor(s, 16); s += __shfl_xor(s, 32);
                if (fq == 0) __hip_atomic_fetch_add(ssq_next + row, s, __ATOMIC_RELAXED, __HIP_MEMORY_SCOPE_AGENT);
                asm volatile("" ::: "memory"); }
    }
};

#define XB_TMO      128
#define XB_XCNT(j)  (256  + 64 * (j))
#define XB_XSUB(j)  (1280 + 64 * (j))
#define XB_XGEN(j)  (2304 + 64 * (j))
#define XB_TOP      3328
#define XB_TOPGEN   3392
#define XCD_BAR_WORDS 3456
#define XB_SPIN_CAP (1u << 20)
__device__ __forceinline__ unsigned xb_ld(unsigned* p)              { return __hip_atomic_load(p, __ATOMIC_RELAXED, __HIP_MEMORY_SCOPE_AGENT); }
__device__ __forceinline__ unsigned xb_add(unsigned* p, unsigned v) { return __hip_atomic_fetch_add(p, v, __ATOMIC_RELAXED, __HIP_MEMORY_SCOPE_AGENT); }
__device__ __forceinline__ unsigned xb_xcc_id() { return (unsigned)__builtin_amdgcn_s_getreg((3 << 11) | 20) & 0xFu; }
#define XB_SPIN(cond, bar) do { unsigned _sp = 0; while (cond) { __builtin_amdgcn_s_sleep(1); \
    if ((++_sp & 255u) == 0u) { if (xb_ld(&(bar)[XB_TMO])) break; if (_sp > XB_SPIN_CAP) { atomicAdd(&(bar)[XB_TMO], 1u); break; } } } } while (0)
struct XcdBarrier { unsigned* bar; unsigned x; volatile LAS unsigned* st; };
__device__ __forceinline__ XcdBarrier xcd_barrier_post(unsigned* bar, volatile LAS unsigned* st) {
    XcdBarrier b; b.bar = bar; b.x = xb_xcc_id(); b.st = st;
    if (threadIdx.x == 0) (void)xb_add(&bar[XB_XCNT(b.x)], 1u);
    return b;
}
__device__ __forceinline__ void xcd_barrier_complete(unsigned* bar, unsigned x, unsigned& nloc, unsigned& nx) {
    const unsigned G = gridDim.x * gridDim.y * gridDim.z;
    unsigned sum, cnt, mine, sp = 0u;
    for (;;) {
        sum = 0u; cnt = 0u; mine = 0u;
#pragma unroll
        for (unsigned j = 0; j < 16; ++j) { const unsigned c = xb_ld(&bar[XB_XCNT(j)]); sum += c; cnt += (c > 0u) ? 1u : 0u; mine = (j == x) ? c : mine; }
        if (sum == G) break;
        __builtin_amdgcn_s_sleep(1);
        if ((++sp & 255u) == 0u) { if (xb_ld(&bar[XB_TMO])) break; if (sp > XB_SPIN_CAP) { atomicAdd(&bar[XB_TMO], 1u); break; } }
    }
    nloc = mine > 0u ? mine : 1u; nx = cnt > 0u ? cnt : 1u;
}
__device__ __forceinline__ void xcd_barrier(const XcdBarrier& b) {
    asm volatile("s_waitcnt vmcnt(0)" ::: "memory");
    __syncthreads();
    if (threadIdx.x == 0) {
        unsigned* bar = b.bar;
        __builtin_amdgcn_s_waitcnt(0);
        unsigned nloc = b.st[0], nx = b.st[1];
        if (nloc == 0u) { xcd_barrier_complete(bar, b.x, nloc, nx); b.st[0] = nloc; b.st[1] = nx; }
        const unsigned old = xb_add(&bar[XB_XSUB(b.x)], 1u);
        const unsigned gen = old / nloc;
        if (old + 1u == (gen + 1u) * nloc) {
            __builtin_amdgcn_fence(__ATOMIC_RELEASE, "agent");
            asm volatile("s_waitcnt vmcnt(0)" ::: "memory");
            const unsigned og = xb_add(&bar[XB_TOP], 1u);
            const unsigned tg = og / nx;
            if (og + 1u == (tg + 1u) * nx) xb_add(&bar[XB_TOPGEN], 1u);
            else XB_SPIN(xb_ld(&bar[XB_TOPGEN]) == tg, bar);
            __builtin_amdgcn_fence(__ATOMIC_ACQUIRE, "agent");
            xb_add(&bar[XB_XGEN(b.x)], 1u);
            asm volatile("s_waitcnt vmcnt(0)" ::: "memory");
        } else {
            XB_SPIN(xb_ld(&bar[XB_XGEN(b.x)]) == gen, bar);
            __builtin_amdgcn_fence(__ATOMIC_ACQUIRE, "agent");
            asm volatile("s_waitcnt vmcnt(0)" ::: "memory");
        }
    }
    __syncthreads();
}

struct Args { const float* in[14]; float* out; unsigned char* ws; int ph_lo, ph_hi; };
struct Frame {
    LAS unsigned char* lds;
    int tid, lane, wave, G, bid;
};
constexpr int PT_OFF = LDS_BYTES - 512;
__device__ __forceinline__ unsigned long long ptab(const Frame& F, int i) {
    volatile LAS unsigned* t = (volatile LAS unsigned*)(F.lds + PT_OFF) + 2 * i;
    const unsigned lo = __builtin_amdgcn_readfirstlane(t[0]), hi = __builtin_amdgcn_readfirstlane(t[1]);
    return ((unsigned long long)hi << 32) | lo;
}
#define INP(i) ((const float*)ptab(F, (i)))
#define OUTP() ((float*)ptab(F, 14))
#define WSB() ((unsigned char*)ptab(F, 15))
enum { I_XP = 0, I_XS = 1, I_CK = 2, I_CV = 3, I_ST = 4, I_META = 5, I_WIN = 6, I_WOUT = 7, I_NW = 8, I_FW = 9, I_SINK = 10, I_RB = 11, I_LBL = 12, I_HNW = 13 };

__device__ __forceinline__ float wave_sum(float v) {
#pragma unroll
    for (int o = 1; o < 64; o <<= 1) v += __shfl_xor(v, o);
    return v;
}

__device__ __forceinline__ int t5_bucket(int d) {
    if (d < 16) return d;
    const float v = __logf((float)d * (1.f / 16.f)) / 2.0794415416798357f * 16.f;
    int b = 16 + (int)v; return b > 31 ? 31 : b;
}

__device__ __forceinline__ void conv_item(Frame& F, const float* W, int K, int N, bf16_t* WT, const float* sc, int item) {
    const int tid = opq(F.tid), lane = tid & 63, w = tid >> 6; LAS float* T = (LAS float*)F.lds;
    const int nblk = N / 128, kb = item / nblk, nb = item % nblk, k0 = kb * 128, n0 = nb * 128;
    f32x4 v[8];
#pragma unroll
    for (int p = 0; p < 8; ++p) { const int row = p * 16 + w * 2 + (lane >> 5); v[p] = *(const f32x4*)(W + (size_t)(k0 + row) * N + n0 + (lane & 31) * 4); }
#pragma unroll
    for (int p = 0; p < 8; ++p) { const int row = p * 16 + w * 2 + (lane >> 5); const float s = sc ? sc[k0 + row] : 1.f; LAS float* d = T + row * 129 + (lane & 31) * 4;
        d[0] = v[p][0] * s; d[1] = v[p][1] * s; d[2] = v[p][2] * s; d[3] = v[p][3] * s; }
    __syncthreads();
#pragma unroll
    for (int j = 0; j < 4; ++j) { const int o = tid + NTHR * j, kg = o & 15, n = o >> 4; const LAS float* s = T + (kg * 8) * 129 + n;
        u32x4 ov; ov.x = pk2(s[0], s[129]); ov.y = pk2(s[2 * 129], s[3 * 129]); ov.z = pk2(s[4 * 129], s[5 * 129]); ov.w = pk2(s[6 * 129], s[7 * 129]);
        *(u32x4*)(WT + (size_t)(n0 + n) * K + k0 + kg * 8) = ov; }
    __syncthreads();
}
constexpr int CI_IN = (DM / 128) * (DIN / 128), CI_OUT = (DM / 128) * (DM / 128), CI_LAYER = CI_IN + CI_OUT;
__device__ __forceinline__ void conv_layer(Frame& F, int l, int first, int stride) {
    unsigned char* const ws = WSB();
    const float* const in_w_in = INP(I_WIN); const float* const in_w_out = INP(I_WOUT); const float* const in_norm_w = INP(I_NW);
#pragma unroll 1
    for (int it = first; it < CI_LAYER; it += stride) {
        if (it < CI_IN) conv_item(F, in_w_in + (size_t)l * DM * DIN, DM, DIN, WSP(bf16_t, WS_WIN) + (size_t)l * DIN * DM, in_norm_w + l * DM, it);
        else conv_item(F, in_w_out + (size_t)l * DM * DM, DM, DM, WSP(bf16_t, WS_WOUT) + (size_t)l * DM * DM, nullptr, it - CI_IN);
    }
}

__device__ __forceinline__ void phase_prologue(Frame& F) {
    conv_layer(F, 0, F.bid, F.G);
    unsigned char* const ws = WSB(); float* const out = OUTP();
    const int gw = F.bid * NWAVES + F.wave, NGW = F.G * NWAVES;
    const float* const in_meta = INP(I_META); const float* const in_x_prompt = INP(I_XP); const float* const in_x_sample = INP(I_XS);
    for (int row = gw; row < MPAD; row += NGW) {
        const float* src = nullptr;
        if (row < MPR) { const int b = row / LP, t = row - b * LP; src = t < NMETA ? in_meta + (size_t)t * DM : in_x_prompt + ((size_t)b * SEQ + (t - NMETA)) * DM; }
        else if (row < MTOT) src = in_x_sample + (size_t)(row - MPR) * DM;
        float s = 0.f;
#pragma unroll
        for (int j = 0; j < 8; ++j) { const int c = (F.lane + 64 * j) * 4; f32x4 v = src ? *(const f32x4*)(src + c) : (f32x4){0.f, 0.f, 0.f, 0.f};
            u32x2 w; w.x = pk2(v[0], v[1]); w.y = pk2(v[2], v[3]); *(u32x2*)(WSP(bf16_t, WS_HB) + (size_t)row * DM + c) = w;
            s += (v[0] * v[0] + v[1] * v[1]) + (v[2] * v[2] + v[3] * v[3]); }
        s = wave_sum(s);
        if (F.lane == 0) WSP(float, WS_SSQ)[row] = s;
    }
    const int gt = F.bid * NTHR + F.tid, NGT = F.G * NTHR;
    const float* const in_lb_logits = INP(I_LBL); const float* const in_rel_bias = INP(I_RB); const float* const in_cache_k = INP(I_CK); const float* const in_cache_v = INP(I_CV);
    for (int c = gt; c < 1024; c += NGT) {
        float v[4], mx = -INFINITY;
#pragma unroll
        for (int l = 0; l < 4; ++l) { v[l] = in_lb_logits[l * 1024 + c]; mx = fmaxf(mx, v[l]); }
        float sum = 0.f;
#pragma unroll
        for (int l = 0; l < 4; ++l) { v[l] = expf(v[l] - mx); sum += v[l]; }
        float cum = 0.f; const float p0 = v[0] / sum;
#pragma unroll
        for (int l = 0; l < 4; ++l) { cum += v[l] / sum; WSP(float, WS_LB)[l * 1024 + c] = cum - p0; }
    }
    for (int i = gt; i < 16 * 128; i += NGT) { const int h = i >> 7, d = i & 127; WSP(float, WS_BIAS)[i] = in_rel_bias[t5_bucket(d) * 16 + h]; }
    { constexpr int PERLB = (WIN - DSEQ) * 256 / 4;
      constexpr int TOT = DEPTH * DBATCH * PERLB;
      for (int i = gt; i < TOT; i += NGT) { const int lbi = i / PERLB, r = i % PERLB; const size_t so = (size_t)lbi * WIN * 256 + (size_t)DSEQ * 256 + (size_t)r * 4, dofs = (size_t)lbi * WIN * 256 + (size_t)r * 4;
          *(f32x4*)(out + O_SCK + dofs) = *(const f32x4*)(in_cache_k + so); *(f32x4*)(out + O_SCV + dofs) = *(const f32x4*)(in_cache_v + so); } }
}

__device__ __forceinline__ bf16x8 ldfrag(const LAS unsigned char* base, int row, int stride_b, int kelem) { return *(const LAS bf16x8*)(base + row * stride_b + kelem * 2); }
#define MMA16(acc, nfrag, mfrag) acc = __builtin_amdgcn_mfma_f32_16x16x32_bf16(nfrag, mfrag, acc, 0, 0, 0)

constexpr int AT_QS = 0, AT_KS = 18432, AT_VT = 41472, AT_PS = 62976, AT_BT = 105984;
template <bool SAMPLE>
__device__ __forceinline__ void attn_unit(Frame& F, int l, int unit) {
    const int tid = opq(F.tid), lane = tid & 63, w = F.wave, fr = lane & 15, fq = lane >> 4;
    LAS unsigned char* lds = F.lds;
    int b, kvh, p0, nq, rowbase;
    unsigned char* const ws = WSB(); const float* const in_cache_k = INP(I_CK); const float* const in_cache_v = INP(I_CV); const float* const in_sinks = INP(I_SINK);
    constexpr int QH = SAMPLE ? 8 : 32, NR = SAMPLE ? 32 : 128;
    if (SAMPLE) { b = unit >> 2; kvh = unit & 3; p0 = 0; nq = 8; rowbase = MPR + b * DSEQ; }
    else { const int bk = unit / 65, blk = unit % 65; b = bk >> 2; kvh = bk & 3; p0 = blk * 32; nq = (LP - p0) < 32 ? (LP - p0) : 32; rowbase = b * LP; }
    const int kbase = p0 - WIN;
#pragma unroll
    for (int r = 0; r < 2; ++r) { const int q = tid + NTHR * r, row = q >> 3, c8 = q & 7; u32x4 v = (u32x4){0u, 0u, 0u, 0u};
        if (row < NR) { const int hl = row / QH, qi = row % QH; if (qi < nq) v = *(const u32x4*)(WSP(bf16_t, WS_Q) + (size_t)(rowbase + p0 + qi) * 1024 + (kvh * 4 + hl) * 64 + c8 * 8); }
        *(LAS u32x4*)(lds + AT_QS + row * 144 + c8 * 16) = v; }
#pragma unroll
    for (int r = 0; r < 3; ++r) { const int q = tid + NTHR * r; if (q < 1280) { const int j = q >> 3, c8 = q & 7, kp = kbase + j; u32x4 v = (u32x4){0u, 0u, 0u, 0u};
        if (SAMPLE) {
            if (j < WIN) { const float* src = in_cache_k + ((((size_t)l * DBATCH + b) * WIN + j) * 4 + kvh) * 64 + c8 * 8; const f32x4 a = *(const f32x4*)src, c = *(const f32x4*)(src + 4); v = pack8(a, c); }
            else if (j < WIN + DSEQ) v = *(const u32x4*)(WSP(bf16_t, WS_KB) + (size_t)(rowbase + j - WIN) * 256 + kvh * 64 + c8 * 8);
        } else { if (kp >= 0 && kp < LP) v = *(const u32x4*)(WSP(bf16_t, WS_KB) + (size_t)(rowbase + kp) * 256 + kvh * 64 + c8 * 8); }
        *(LAS u32x4*)(lds + AT_KS + j * 144 + c8 * 16) = v; } }
#pragma unroll
    for (int r = 0; r < 3; ++r) { const int q = tid + NTHR * r; if (q < 1280) { const int j = q % 160, c8 = q / 160, kp = kbase + j; u32x4 v = (u32x4){0u, 0u, 0u, 0u};
        if (SAMPLE) {
            if (j < WIN) { const float* src = in_cache_v + ((((size_t)l * DBATCH + b) * WIN + j) * 4 + kvh) * 64 + c8 * 8; const f32x4 a = *(const f32x4*)src, c = *(const f32x4*)(src + 4); v = pack8(a, c); }
            else if (j < WIN + DSEQ) v = *(const u32x4*)(WSP(bf16_t, WS_VB) + (size_t)(rowbase + j - WIN) * 256 + kvh * 64 + c8 * 8);
        } else { if (kp >= 0 && kp < LP) v = *(const u32x4*)(WSP(bf16_t, WS_VB) + (size_t)(rowbase + kp) * 256 + kvh * 64 + c8 * 8); }
        LAS unsigned short* vt = (LAS unsigned short*)(lds + AT_VT) + (c8 * 8) * 168 + j;
        vt[0 * 168] = (unsigned short)(v.x & 0xffffu); vt[1 * 168] = (unsigned short)(v.x >> 16); vt[2 * 168] = (unsigned short)(v.y & 0xffffu); vt[3 * 168] = (unsigned short)(v.y >> 16);
        vt[4 * 168] = (unsigned short)(v.z & 0xffffu); vt[5 * 168] = (unsigned short)(v.z >> 16); vt[6 * 168] = (unsigned short)(v.w & 0xffffu); vt[7 * 168] = (unsigned short)(v.w >> 16); } }
    ((LAS float*)(lds + AT_BT))[tid] = WSP(float, WS_BIAS)[(kvh * 4 + (tid >> 7)) * 128 + (tid & 127)];
    __syncthreads();
    if (w * 16 < NR) {
        f32x4 acc[10];
#pragma unroll
        for (int n = 0; n < 10; ++n) acc[n] = (f32x4){0.f, 0.f, 0.f, 0.f};
#pragma unroll
        for (int ks = 0; ks < 2; ++ks) { const bf16x8 mf = ldfrag(lds + AT_QS, w * 16 + fr, 144, ks * 32 + fq * 8);
#pragma unroll
            for (int n = 0; n < 10; ++n) { const bf16x8 nf = ldfrag(lds + AT_KS, n * 16 + fr, 144, ks * 32 + fq * 8); MMA16(acc[n], nf, mf); } }
        const int r = w * 16 + fr, hl = r / QH, qi = r % QH, p = p0 + qi;
        const bool rowok = qi < nq;
        const LAS float* bt = (const LAS float*)(lds + AT_BT) + hl * 128;
        const int kmin = SAMPLE ? -WIN : 0;
        float mx = -INFINITY;
#pragma unroll
        for (int n = 0; n < 10; ++n)
#pragma unroll
            for (int e = 0; e < 4; ++e) { const int kp = kbase + n * 16 + fq * 4 + e, dist = p - kp; const bool ok = rowok && dist >= 0 && dist < WIN && kp >= kmin;
                const float s = ok ? acc[n][e] + bt[dist & 127] : -INFINITY; acc[n][e] = s; mx = fmaxf(mx, s); }
        mx = fmaxf(mx, __shfl_xor(mx, 16)); mx = fmaxf(mx, __shfl_xor(mx, 32));
        const float sink = in_sinks[l * 16 + kvh * 4 + hl];
        const float mm = fmaxf(mx, sink);
        float sum = 0.f;
#pragma unroll
        for (int n = 0; n < 10; ++n)
#pragma unroll
            for (int e = 0; e < 4; ++e) { const float ev = __expf(acc[n][e] - mm); acc[n][e] = ev; sum += ev; }
        sum += __shfl_xor(sum, 16); sum += __shfl_xor(sum, 32);
        const float inv = 1.f / (sum + __expf(sink - mm));
#pragma unroll
        for (int n = 0; n < 10; ++n) { u32x2 pw; pw.x = pk2(acc[n][0] * inv, acc[n][1] * inv); pw.y = pk2(acc[n][2] * inv, acc[n][3] * inv);
            *(LAS u32x2*)(lds + AT_PS + r * 336 + (n * 16 + fq * 4) * 2) = pw; }
        LDS_WAIT(); asm volatile("" ::: "memory");
        f32x4 o[4];
#pragma unroll
        for (int n = 0; n < 4; ++n) o[n] = (f32x4){0.f, 0.f, 0.f, 0.f};
#pragma unroll
        for (int ks = 0; ks < 5; ++ks) { const bf16x8 mf = ldfrag(lds + AT_PS, r, 336, ks * 32 + fq * 8);
#pragma unroll
            for (int n = 0; n < 4; ++n) { const bf16x8 nf = ldfrag(lds + AT_VT, n * 16 + fr, 336, ks * 32 + fq * 8); MMA16(o[n], nf, mf); } }
        if (rowok) { const size_t grow = (size_t)(rowbase + p); const int hc = (kvh * 4 + hl) * 64;
#pragma unroll
            for (int n = 0; n < 4; ++n) { const int d = n * 16 + fq * 4; const u32x2 g = *(const u32x2*)(WSP(bf16_t, WS_GA) + grow * 1024 + hc + d);
                u32x2 yw; yw.x = pk2(o[n][0] * bflo(g.x), o[n][1] * bfhi(g.x)); yw.y = pk2(o[n][2] * bflo(g.y), o[n][3] * bfhi(g.y));
                *(u32x2*)(WSP(bf16_t, WS_Y) + grow * DM + hc + d) = yw; } }
    }
    __syncthreads();
}

constexpr int HS_F = 0, HS_K = 4096, HS_Q = 8192, HS_OP = 12288  , HS_O = 28672  ;
__device__ __forceinline__ void hgrn_sample_unit(Frame& F, int l, int unit) {
    const int tid = opq(F.tid), lane = tid & 63, w = F.wave; LAS unsigned char* lds = F.lds;
    unsigned char* const ws = WSB(); float* const out = OUTP(); const float* const in_state_h = INP(I_ST); const float* const in_hnorm_w = INP(I_HNW);
    const int b = unit >> 3, h = unit & 7, dv = tid & 127, qd = tid >> 7, rowbase = MPR + b * DSEQ;
    const size_t sbase = ((((size_t)l * DBATCH + b) * 8 + h) * 128) * 128;
    float S[32];
#pragma unroll
    for (int i = 0; i < 32; ++i) S[i] = in_state_h[sbase + (size_t)(qd * 32 + i) * 128 + dv];
#pragma unroll
    for (int r = 0; r < 2; ++r) { const int e = tid + NTHR * r, t = e >> 7, d = e & 127; const size_t o = (size_t)(rowbase + t) * 1024 + h * 128 + d;
        ((LAS float*)(lds + HS_F))[e] = __expf(WSP(float, WS_LOGF)[o]); ((LAS float*)(lds + HS_K))[e] = bf2f(WSP(bf16_t, WS_KR)[o]); ((LAS float*)(lds + HS_Q))[e] = bf2f(WSP(bf16_t, WS_QR)[o]); }
    float vv[8];
#pragma unroll
    for (int t = 0; t < 8; ++t) vv[t] = bf2f(WSP(bf16_t, WS_IR)[(size_t)(rowbase + t) * 1024 + h * 128 + dv]);
    __syncthreads();
#pragma unroll
    for (int t = 0; t < 8; ++t) { const LAS float* fp = (const LAS float*)(lds + HS_F) + t * 128 + qd * 32; const LAS float* kp = (const LAS float*)(lds + HS_K) + t * 128 + qd * 32; const LAS float* qp = (const LAS float*)(lds + HS_Q) + t * 128 + qd * 32;
        float part = 0.f;
#pragma unroll
        for (int i = 0; i < 32; ++i) { S[i] = fp[i] * S[i] + kp[i] * vv[t]; part += S[i] * qp[i]; }
        ((LAS float*)(lds + HS_OP))[(t * 4 + qd) * 128 + dv] = part; }
#pragma unroll
    for (int i = 0; i < 32; ++i) out[O_SSH + sbase + (size_t)(qd * 32 + i) * 128 + dv] = S[i];
    __syncthreads();
    { const int t = w; const LAS float* op = (const LAS float*)(lds + HS_OP) + t * 512;
      const float o0 = op[lane] + op[128 + lane] + op[256 + lane] + op[384 + lane], o1 = op[64 + lane] + op[192 + lane] + op[320 + lane] + op[448 + lane];
      const float ss = wave_sum(o0 * o0 + o1 * o1), rn = rsqrtf(ss * (1.f / 128.f) + EPS);
      const size_t row = (size_t)(rowbase + t); const int c0 = h * 128 + lane, c1 = c0 + 64;
      const float y0 = o0 * rn * in_hnorm_w[l * 1024 + c0] * bf2f(WSP(bf16_t, WS_GR)[row * 1024 + c0]), y1 = o1 * rn * in_hnorm_w[l * 1024 + c1] * bf2f(WSP(bf16_t, WS_GR)[row * 1024 + c1]);
      WSP(bf16_t, WS_Y)[row * DM + 1024 + c0] = (bf16_t)f2bf(y0); WSP(bf16_t, WS_Y)[row * DM + 1024 + c1] = (bf16_t)f2bf(y1); }
    __syncthreads();
}

constexpr int HC_A = 0, HC_ASTR = 132, HC_TOT = 33792  , HC_END = 35840;
__device__ __forceinline__ void chunk_cumsum(Frame& F, int b, int h, int c) {
    const int tid = opq(F.tid); LAS float* A = (LAS float*)(F.lds + HC_A); LAS float* TOT = (LAS float*)(F.lds + HC_TOT);
    unsigned char* const ws = WSB();
#pragma unroll
    for (int r = 0; r < 4; ++r) { const int q = tid + NTHR * r, i = q >> 5, c4 = q & 31, t = 64 * c - 48 + i; f32x4 v = (f32x4){0.f, 0.f, 0.f, 0.f};
        if (t >= 0) v = *(const f32x4*)(WSP(float, WS_LOGF) + (size_t)(b * LP + t) * 1024 + h * 128 + c4 * 4);
        *(LAS f32x4*)(A + i * HC_ASTR + c4 * 4) = v; }
    __syncthreads();
    const int d = tid & 127, sg = tid >> 7; float v[16]; float run = 0.f;
#pragma unroll
    for (int i = 0; i < 16; ++i) { run += A[(sg * 16 + i) * HC_ASTR + d]; v[i] = run; }
    TOT[sg * 128 + d] = run;
    __syncthreads();
    float off = 0.f;
#pragma unroll
    for (int s = 0; s < 3; ++s) if (s < sg) off += TOT[s * 128 + d];
#pragma unroll
    for (int i = 0; i < 16; ++i) A[(sg * 16 + i) * HC_ASTR + d] = v[i] + off;
    __syncthreads();
}
template <int MODE  >
__device__ __forceinline__ void chunk_transpose(Frame& F, const bf16_t* src, int b, int h, int c, int dst_off) {
    const int tid = opq(F.tid), i = tid & 63, t = 64 * c - 48 + i; const LAS float* A = (const LAS float*)(F.lds + HC_A);
#pragma unroll
    for (int r = 0; r < 2; ++r) { const int c8 = (tid >> 6) + 8 * r; u32x4 v = (u32x4){0u, 0u, 0u, 0u};
        if (t >= 0) v = *(const u32x4*)(src + (size_t)(b * LP + t) * 1024 + h * 128 + c8 * 8);
        float x[8] = {bflo(v.x), bfhi(v.x), bflo(v.y), bfhi(v.y), bflo(v.z), bfhi(v.z), bflo(v.w), bfhi(v.w)};
        LAS unsigned short* dst = (LAS unsigned short*)(F.lds + dst_off) + (c8 * 8) * 72 + i;
#pragma unroll
        for (int e = 0; e < 8; ++e) { float y = x[e]; if (MODE == 1) y *= __expf(A[63 * HC_ASTR + c8 * 8 + e] - A[i * HC_ASTR + c8 * 8 + e]); dst[e * 72] = (unsigned short)f2bf(y); } }
}

constexpr int HA_KT = HC_END, HA_VT = HA_KT + 18432;
__device__ __forceinline__ void hgrn_passA_unit(Frame& F, int uid) {
    unsigned char* const ws = WSB();
    const int bh = uid / NCH, c = uid % NCH, b = bh >> 3, h = bh & 7, tid = opq(F.tid), lane = tid & 63, w = F.wave, fr = lane & 15, fq = lane >> 4; LAS unsigned char* lds = F.lds;
    chunk_cumsum(F, b, h, c);
    chunk_transpose<1>(F, WSP(bf16_t, WS_KR), b, h, c, HA_KT);
    chunk_transpose<0>(F, WSP(bf16_t, WS_IR), b, h, c, HA_VT);
    if (tid < 128) WSP(float, WS_GD)[(size_t)uid * 128 + tid] = __expf(((const LAS float*)(lds + HC_A))[63 * HC_ASTR + tid]);
    __syncthreads();
    f32x4 acc[8];
#pragma unroll
    for (int n = 0; n < 8; ++n) acc[n] = (f32x4){0.f, 0.f, 0.f, 0.f};
#pragma unroll
    for (int ks = 0; ks < 2; ++ks) { const bf16x8 mf = ldfrag(lds + HA_VT, w * 16 + fr, 144, ks * 32 + fq * 8);
#pragma unroll
        for (int n = 0; n < 8; ++n) { const bf16x8 nf = ldfrag(lds + HA_KT, n * 16 + fr, 144, ks * 32 + fq * 8); MMA16(acc[n], nf, mf); } }
    float* ut = WSP(float, WS_UT) + (size_t)uid * 16384 + (size_t)(w * 16 + fr) * 128;
#pragma unroll
    for (int n = 0; n < 8; ++n) *(f32x4*)(ut + n * 16 + fq * 4) = acc[n];
    __syncthreads();
}

__device__ __forceinline__ void hgrn_scan_unit(Frame& F, int l, int unit) {
    unsigned char* const ws = WSB(); float* const out = OUTP();
    const int bh = unit >> 3, sl = unit & 7, tid = opq(F.tid), dvr = sl * 16 + (tid >> 5), dk = (tid & 31) * 4;
    f32x4 S = (f32x4){0.f, 0.f, 0.f, 0.f};
#pragma unroll 1
    for (int cb = 0; cb < NCH; cb += 11) {
        f32x4 ub[11], gb[11];
#pragma unroll
        for (int j = 0; j < 11; ++j) { const size_t uid = (size_t)bh * NCH + cb + j; ub[j] = *(const f32x4*)(WSP(float, WS_UT) + uid * 16384 + (size_t)dvr * 128 + dk); gb[j] = *(const f32x4*)(WSP(float, WS_GD) + uid * 128 + dk); }
#pragma unroll
        for (int j = 0; j < 11; ++j) { const size_t uid = (size_t)bh * NCH + cb + j; u32x2 sw; sw.x = pk2(S[0], S[1]); sw.y = pk2(S[2], S[3]);
            *(u32x2*)(WSP(bf16_t, WS_STB) + uid * 16384 + (size_t)dvr * 128 + dk) = sw; S = gb[j] * S + ub[j]; }
    }
    float* o = out + O_PSH + (((size_t)l * NBATCH * 8 + bh) * 128) * 128;
#pragma unroll
    for (int e = 0; e < 4; ++e) o[(size_t)(dk + e) * 128 + dvr] = S[e];
}

constexpr int HCc_QT = HC_END, HCc_KH = HCc_QT + 17408, HCc_VT = HCc_KH + 17408, HCc_SP = HCc_VT + 18432, HCc_PS = HCc_SP + 34816, HCc_RED = HCc_PS + 9216, HCc_END = HCc_RED + 512;
static_assert(HCc_END <= LDS_BYTES - 512, "pass C LDS");
__device__ __forceinline__ void hgrn_passC_unit(Frame& F, int l, int uid) {
    unsigned char* const ws = WSB(); const float* const in_hnorm_w = INP(I_HNW);
    const int bh = uid / NCH, c = uid % NCH, b = bh >> 3, h = bh & 7, tid = opq(F.tid), lane = tid & 63, w = F.wave, fr = lane & 15, fq = lane >> 4; LAS unsigned char* lds = F.lds;
    chunk_cumsum(F, b, h, c);
    const LAS float* A = (const LAS float*)(lds + HC_A);
#pragma unroll
    for (int r = 0; r < 2; ++r) { const int q = tid + NTHR * r, i = q >> 4, c8 = q & 15, t = 64 * c - 48 + i; u32x4 qv = (u32x4){0u, 0u, 0u, 0u}, kv = qv;
        if (t >= 0) { const size_t o = (size_t)(b * LP + t) * 1024 + h * 128 + c8 * 8; qv = *(const u32x4*)(WSP(bf16_t, WS_QR) + o); kv = *(const u32x4*)(WSP(bf16_t, WS_KR) + o); }
        const f32x4 a0 = *(const LAS f32x4*)(A + i * HC_ASTR + c8 * 8), a1 = *(const LAS f32x4*)(A + i * HC_ASTR + c8 * 8 + 4);
        const f32x4 r0 = *(const LAS f32x4*)(A + 31 * HC_ASTR + c8 * 8), r1 = *(const LAS f32x4*)(A + 31 * HC_ASTR + c8 * 8 + 4);
        f32x4 eq0, eq1, ek0, ek1;
#pragma unroll
        for (int e = 0; e < 4; ++e) { eq0[e] = __expf(a0[e] - r0[e]); eq1[e] = __expf(a1[e] - r1[e]); ek0[e] = __expf(r0[e] - a0[e]); ek1[e] = __expf(r1[e] - a1[e]); }
        const f32x4 q0 = (f32x4){bflo(qv.x), bfhi(qv.x), bflo(qv.y), bfhi(qv.y)} * eq0, q1 = (f32x4){bflo(qv.z), bfhi(qv.z), bflo(qv.w), bfhi(qv.w)} * eq1;
        const f32x4 k0 = (f32x4){bflo(kv.x), bfhi(kv.x), bflo(kv.y), bfhi(kv.y)} * ek0, k1 = (f32x4){bflo(kv.z), bfhi(kv.z), bflo(kv.w), bfhi(kv.w)} * ek1;
        *(LAS u32x4*)(lds + HCc_QT + i * 272 + c8 * 16) = pack8(q0, q1); *(LAS u32x4*)(lds + HCc_KH + i * 272 + c8 * 16) = pack8(k0, k1); }
    chunk_transpose<0>(F, WSP(bf16_t, WS_IR), b, h, c, HCc_VT);
#pragma unroll
    for (int r = 0; r < 4; ++r) { const int q = tid + NTHR * r, dvr = q >> 4, c8 = q & 15; const u32x4 sv = *(const u32x4*)(WSP(bf16_t, WS_STB) + (size_t)uid * 16384 + (size_t)dvr * 128 + c8 * 8);
        const f32x4 r0 = *(const LAS f32x4*)(A + 31 * HC_ASTR + c8 * 8), r1 = *(const LAS f32x4*)(A + 31 * HC_ASTR + c8 * 8 + 4);
        f32x4 s0 = (f32x4){bflo(sv.x), bfhi(sv.x), bflo(sv.y), bfhi(sv.y)}, s1 = (f32x4){bflo(sv.z), bfhi(sv.z), bflo(sv.w), bfhi(sv.w)};
#pragma unroll
        for (int e = 0; e < 4; ++e) { s0[e] *= __expf(r0[e]); s1[e] *= __expf(r1[e]); }
        *(LAS u32x4*)(lds + HCc_SP + dvr * 272 + c8 * 16) = pack8(s0, s1); }
    __syncthreads();
    { const int mt = w >> 1;
      f32x4 p[2];
#pragma unroll
      for (int j = 0; j < 2; ++j) p[j] = (f32x4){0.f, 0.f, 0.f, 0.f};
#pragma unroll
      for (int ks = 0; ks < 4; ++ks) { const bf16x8 mf = ldfrag(lds + HCc_QT, mt * 16 + fr, 272, ks * 32 + fq * 8);
#pragma unroll
          for (int j = 0; j < 2; ++j) { const int nt = (w & 1) * 2 + j; const bf16x8 nf = ldfrag(lds + HCc_KH, nt * 16 + fr, 272, ks * 32 + fq * 8); MMA16(p[j], nf, mf); } }
#pragma unroll
      for (int j = 0; j < 2; ++j) { const int nt = (w & 1) * 2 + j, ti = mt * 16 + fr, s0 = nt * 16 + fq * 4; float pv[4];
#pragma unroll
          for (int e = 0; e < 4; ++e) pv[e] = (s0 + e <= ti) ? p[j][e] : 0.f;
          u32x2 pw; pw.x = pk2(pv[0], pv[1]); pw.y = pk2(pv[2], pv[3]); *(LAS u32x2*)(lds + HCc_PS + ti * 144 + s0 * 2) = pw; } }
    __syncthreads();
    { const int mt = w & 3, nb = (w >> 2) * 4; f32x4 o[4];
#pragma unroll
      for (int n = 0; n < 4; ++n) o[n] = (f32x4){0.f, 0.f, 0.f, 0.f};
#pragma unroll
      for (int ks = 0; ks < 2; ++ks) { const bf16x8 mf = ldfrag(lds + HCc_PS, mt * 16 + fr, 144, ks * 32 + fq * 8);
#pragma unroll
          for (int n = 0; n < 4; ++n) { const bf16x8 nf = ldfrag(lds + HCc_VT, (nb + n) * 16 + fr, 144, ks * 32 + fq * 8); MMA16(o[n], nf, mf); } }
#pragma unroll
      for (int ks = 0; ks < 4; ++ks) { const bf16x8 mf = ldfrag(lds + HCc_QT, mt * 16 + fr, 272, ks * 32 + fq * 8);
#pragma unroll
          for (int n = 0; n < 4; ++n) { const bf16x8 nf = ldfrag(lds + HCc_SP, (nb + n) * 16 + fr, 272, ks * 32 + fq * 8); MMA16(o[n], nf, mf); } }
      float ss = 0.f;
#pragma unroll
      for (int n = 0; n < 4; ++n) ss += (o[n][0] * o[n][0] + o[n][1] * o[n][1]) + (o[n][2] * o[n][2] + o[n][3] * o[n][3]);
      ss += __shfl_xor(ss, 16); ss += __shfl_xor(ss, 32);
      const int ti = mt * 16 + fr;
      if (fq == 0) ((LAS float*)(lds + HCc_RED))[(w >> 2) * 64 + ti] = ss;
      __syncthreads();
      const float tot = ((const LAS float*)(lds + HCc_RED))[ti] + ((const LAS float*)(lds + HCc_RED))[64 + ti];
      const float rn = rsqrtf(tot * (1.f / 128.f) + EPS);
      const int t = 64 * c - 48 + ti;
      if (t >= 0) { const size_t row = (size_t)(b * LP + t);
#pragma unroll
          for (int n = 0; n < 4; ++n) { const int col = h * 128 + (nb + n) * 16 + fq * 4; const f32x4 nw = *(const f32x4*)(in_hnorm_w + l * 1024 + col); const u32x2 g = *(const u32x2*)(WSP(bf16_t, WS_GR) + row * 1024 + col);
              u32x2 yw; yw.x = pk2(o[n][0] * rn * nw[0] * bflo(g.x), o[n][1] * rn * nw[1] * bfhi(g.x)); yw.y = pk2(o[n][2] * rn * nw[2] * bflo(g.y), o[n][3] * rn * nw[3] * bfhi(g.y));
              *(u32x2*)(WSP(bf16_t, WS_Y) + row * DM + 1024 + col) = yw; } } }
    __syncthreads();
}

__device__ __forceinline__ void phase_final(Frame& F) {
    unsigned char* const ws = WSB(); float* const out = OUTP(); const float* const in_final_w = INP(I_FW);
    const int gw = F.bid * NWAVES + F.wave, NGW = F.G * NWAVES; const float* ssq = WSP(float, WS_SSQ) + 4 * MPAD;
    for (int i = gw; i < NBATCH * SEQ + MSA; i += NGW) {
        int row; float* dst;
        if (i < NBATCH * SEQ) { const int b = i / SEQ, s = i % SEQ; row = b * LP + NMETA + s; dst = out + O_YP + (size_t)i * DM; }
        else { row = MPR + (i - NBATCH * SEQ); dst = out + O_YS + (size_t)(i - NBATCH * SEQ) * DM; }
        const float rs = rsqrtf(ssq[row] * (1.f / 2048.f) + EPS);
#pragma unroll
        for (int j = 0; j < 4; ++j) { const int c = (F.lane + 64 * j) * 8; const u32x4 hv = *(const u32x4*)(WSP(bf16_t, WS_HB) + (size_t)row * DM + c);
            const f32x4 w0 = *(const f32x4*)(in_final_w + c), w1 = *(const f32x4*)(in_final_w + c + 4);
            *(f32x4*)(dst + c) = (f32x4){bflo(hv.x), bfhi(hv.x), bflo(hv.y), bfhi(hv.y)} * rs * w0; *(f32x4*)(dst + c + 4) = (f32x4){bflo(hv.z), bfhi(hv.z), bflo(hv.w), bfhi(hv.w)} * rs * w1; }
    }
}

constexpr int NPHASE = 22;
constexpr int REP_PRO = 1, REP_GIN = 1, REP_MIXA = 1, REP_SCAN = 1, REP_PC = 1;
constexpr int NMIXA = NUNIT + 4 * 4 * 65 + DBATCH * 4 + DBATCH * 8;

#ifndef EN_PRO
#define EN_PRO 1
#endif
#ifndef EN_GIN
#define EN_GIN 1
#endif
#ifndef EN_GOUT
#define EN_GOUT 1
#endif
#ifndef EN_PA
#define EN_PA 1
#endif
#ifndef EN_ATT
#define EN_ATT 1
#endif
#ifndef EN_HS
#define EN_HS 1
#endif
#ifndef EN_SCAN
#define EN_SCAN 1
#endif
#ifndef EN_PC
#define EN_PC 1
#endif
#ifndef EN_FIN
#define EN_FIN 1
#endif
__global__ void __launch_bounds__(NTHR, 2) hymba_fwd(Args args) {
    extern __shared__ __attribute__((aligned(16))) unsigned char lds_raw[];
    Frame F;
    F.lds = (LAS unsigned char*)lds_raw;
    F.tid = threadIdx.x; F.lane = F.tid & 63; F.wave = __builtin_amdgcn_readfirstlane(F.tid >> 6); F.G = gridDim.x; F.bid = blockIdx.x;
    volatile LAS unsigned* MISC = (volatile LAS unsigned*)(F.lds + MISC_OFF);
    if (F.tid < 32) MISC[F.tid] = 0u;
    if (F.tid == 0) { LAS unsigned long long* pt = (LAS unsigned long long*)(F.lds + PT_OFF);
#pragma unroll
        for (int i = 0; i < 14; ++i) pt[i] = (unsigned long long)args.in[i];
        pt[14] = (unsigned long long)args.out; pt[15] = (unsigned long long)args.ws; }
    __syncthreads();
    const int lo = args.ph_lo, hi = args.ph_hi;
    XcdBarrier bar; bar.bar = nullptr; bar.x = 0; bar.st = nullptr;
    if ((hi - lo) > 1) bar = xcd_barrier_post((unsigned*)WSB() + CW_BAR, MISC + 8);
#define IN(k) (lo <= (k) && (k) < hi)
#define SEAM(k) do { if (IN(k) && IN((k) + 1)) xcd_barrier(bar); } while (0)

    if (EN_PRO && IN(0)) { for (int rep = 0; rep < REP_PRO; ++rep) phase_prologue(F); }
    SEAM(0);
#pragma unroll 1
    for (int l = 0; l < DEPTH; ++l) {
        const int pb = 1 + 5 * l;
        if (EN_GIN && IN(pb)) {
            unsigned char* const ws = WSB();
            pg8::Gemm g{WSP(bf16_t, WS_HB), WSP(bf16_t, WS_WIN) + (size_t)l * DIN * DM, MPAD, DIN, DM}; pg8::StaticOrder S; S.init(MPAD, DIN, F.G, F.bid);
            EpiIn E; E.ws = ws; E.out = OUTP(); E.l = l;
            for (int rep = 0; rep < REP_GIN; ++rep) pg8::gemm_phase<EpiIn, pg8::StaticOrder>(F.lds, g, S, E);
        }
        SEAM(pb);
        if (IN(pb + 1)) for (int rep = 0; rep < REP_MIXA; ++rep) {
            if (EN_PA) {
#pragma unroll 1
                for (int i = F.bid; i < NUNIT; i += F.G) hgrn_passA_unit(F, i); }
            if (EN_ATT) {
#pragma unroll 1
                for (int i = (F.bid + 224) % F.G; i < 1040; i += F.G) attn_unit<false>(F, l, i); }
            if (EN_ATT) {
#pragma unroll 1
                for (int i = (F.bid + 192) % F.G; i < 128; i += F.G) attn_unit<true>(F, l, i); }
            if (EN_HS) {
#pragma unroll 1
                for (int i = F.bid; i < 256; i += F.G) hgrn_sample_unit(F, l, i); }
        }
        SEAM(pb + 1);
        if (EN_SCAN && IN(pb + 2)) for (int rep = 0; rep < REP_SCAN; ++rep) {
#pragma unroll 1
            for (int i = F.bid; i < 256; i += F.G) hgrn_scan_unit(F, l, i);
        }
        SEAM(pb + 2);
        if (EN_PC && IN(pb + 3)) for (int rep = 0; rep < REP_PC; ++rep) {
#pragma unroll 1
            for (int i = F.bid; i < NUNIT; i += F.G) hgrn_passC_unit(F, l, i);
        }
        SEAM(pb + 3);
        if (EN_GOUT && IN(pb + 4)) {
            unsigned char* const ws = WSB();
            pg8::Gemm g{WSP(bf16_t, WS_Y), WSP(bf16_t, WS_WOUT) + (size_t)l * DM * DM, MPAD, DM, DM}; pg8::StaticOrder S; S.init(MPAD, DM, F.G, F.bid);
            EpiOut E; E.ws = ws; E.l = l;
            pg8::gemm_phase<EpiOut, pg8::StaticOrder>(F.lds, g, S, E);
            if (l + 1 < DEPTH) { const int rem = ((MPAD / 256) * (DM / 256)) % F.G;
                if (F.bid >= rem) conv_layer(F, l + 1, F.bid - rem, F.G - rem); }
        }
        SEAM(pb + 4);
    }
    if (EN_FIN && IN(21)) phase_final(F);
#undef IN
#undef SEAM
}

extern "C" void kernel_launch(void* const* d_in, const int* in_sizes, int n_in, void* d_out, int out_size, void* d_ws, size_t ws_size, hipStream_t stream) {
    static int grid = 0;
    if (grid == 0) {
        if (n_in != 14 || ws_size < WS_END) { fprintf(stderr, "kernel_launch: unexpected problem (n_in %d, ws %zu < %zu)\n", n_in, ws_size, (size_t)WS_END); grid = -1; return; }
        int dev = 0, cus = 0, per_cu = 0;
        if (hipGetDevice(&dev) != hipSuccess || hipDeviceGetAttribute(&cus, hipDeviceAttributeMultiprocessorCount, dev) != hipSuccess) { grid = -1; return; }
        if (hipFuncSetAttribute((const void*)hymba_fwd, hipFuncAttributeMaxDynamicSharedMemorySize, LDS_BYTES) != hipSuccess) { fprintf(stderr, "kernel_launch: hipFuncSetAttribute failed\n"); grid = -1; return; }
        if (hipOccupancyMaxActiveBlocksPerMultiprocessor(&per_cu, (const void*)hymba_fwd, NTHR, LDS_BYTES) != hipSuccess || per_cu < 1) { fprintf(stderr, "kernel_launch: occupancy query says %d blocks per CU\n", per_cu); (void)hipGetLastError(); grid = -1; return; }
        grid = cus;
    }
    if (grid < 0) return;
    (void)hipMemsetAsync((char*)d_ws + WS_CTL, 0, CTL_ZERO_BYTES, stream);
    Args a{};
    for (int i = 0; i < 14; ++i) a.in[i] = (const float*)d_in[i];
    a.out = (float*)d_out; a.ws = (unsigned char*)d_ws;
#if MK_SINGLE
    a.ph_lo = 0; a.ph_hi = NPHASE;
    void* kargs[] = {&a};
    hipError_t e = hipLaunchCooperativeKernel((const void*)hymba_fwd, dim3(grid), dim3(NTHR), kargs, LDS_BYTES, stream);
    if (e != hipSuccess) fprintf(stderr, "kernel_launch: cooperative launch failed: %s (grid %d)\n", hipGetErrorString(e), grid);
#else
    for (int p = 0; p < NPHASE; ++p) { a.ph_lo = p; a.ph_hi = p + 1; hipLaunchKernelGGL(hymba_fwd, dim3(grid), dim3(NTHR), LDS_BYTES, stream, a); }
#endif
}
```

```cpp
#include <hip/hip_runtime.h>
#include <cstdio>
#include <cstdint>

#ifndef MK_SINGLE
#define MK_SINGLE 1
#endif

#define LAS __attribute__((address_space(3)))
#define GAS __attribute__((address_space(1)))
typedef unsigned short bf16_t;
typedef short bf16x8 __attribute__((ext_vector_type(8)));
typedef float f32x4 __attribute__((ext_vector_type(4)));
typedef float f32x2 __attribute__((ext_vector_type(2)));
typedef unsigned u32x4 __attribute__((ext_vector_type(4)));
typedef unsigned u32x2 __attribute__((ext_vector_type(2)));

constexpr int DM = 2048, NBATCH = 4, SEQ = 2048, NMETA = 16, LP = SEQ + NMETA;
constexpr int MPR = NBATCH * LP;
constexpr int DBATCH = 32, DSEQ = 8, MSA = DBATCH * DSEQ;
constexpr int MTOT = MPR + MSA;
constexpr int MPAD = 8704;
constexpr int DIN = 6656, DEPTH = 4, WIN = 128;
constexpr int NCH = 33;
constexpr int NUNIT = NBATCH * 8 * NCH;
constexpr float EPS = 1e-6f;

constexpr size_t O_YP = 0, O_YS = 16777216, O_PCK = 17301504, O_PCV = 17825792, O_PSH = 18350080, O_SCK = 20447232, O_SCV = 24641536, O_SSH = 28835840;

constexpr size_t MiB = 1u << 20;
constexpr size_t WS_CTL = 0, CTL_ZERO_BYTES = 1 * MiB;
constexpr size_t WS_SSQ = 512 * 1024;
constexpr size_t WS_LB = 1 * MiB;
constexpr size_t WS_BIAS = WS_LB + 16384;
constexpr size_t WS_WIN = 2 * MiB;
constexpr size_t WS_WOUT = WS_WIN + (size_t)DEPTH * DIN * DM * 2;
constexpr size_t WS_H = WS_WOUT + (size_t)DEPTH * DM * DM * 2;
constexpr size_t WS_HB = WS_H + (size_t)MPAD * DM * 4;
constexpr size_t WS_Q = WS_HB + (size_t)MPAD * DM * 2;
constexpr size_t SZ1K = (size_t)MPAD * 1024 * 2;
constexpr size_t WS_GA = WS_Q + SZ1K, WS_QR = WS_GA + SZ1K, WS_KR = WS_QR + SZ1K, WS_IR = WS_KR + SZ1K, WS_GR = WS_IR + SZ1K;
constexpr size_t WS_KB = WS_GR + SZ1K;
constexpr size_t WS_VB = WS_KB + (size_t)MPAD * 256 * 2;
constexpr size_t WS_LOGF = WS_VB + (size_t)MPAD * 256 * 2;
constexpr size_t WS_Y = WS_LOGF + (size_t)MPAD * 1024 * 4;
constexpr size_t WS_UT = WS_Y + (size_t)MPAD * DM * 2;
constexpr size_t WS_GD = WS_UT + (size_t)NUNIT * 16384 * 4;
constexpr size_t WS_STB = WS_GD + (size_t)NUNIT * 128 * 4;
constexpr size_t WS_END = WS_STB + (size_t)NUNIT * 16384 * 2;
constexpr int CW_BAR = 4096;

constexpr int NWAVES = 8, NTHR = 512;
constexpr int LDS_BYTES = 147456;
constexpr int RING_BYTES = 131072;
constexpr int MISC_OFF = LDS_BYTES - 256;

#define WSP(T, off) ((T*)(GAS T*)(ws + (off)))
#define LDS_WAIT() asm volatile("s_waitcnt lgkmcnt(0)" ::: "memory")
#define VM_WAIT() asm volatile("s_waitcnt vmcnt(0)" ::: "memory")

__device__ __forceinline__ unsigned f2bf(float f) { unsigned u = __builtin_bit_cast(unsigned, f); return (u + 0x7fffu + ((u >> 16) & 1u)) >> 16; }
__device__ __forceinline__ unsigned pk2(float lo, float hi) { return f2bf(lo) | (f2bf(hi) << 16); }
__device__ __forceinline__ float bf2f(unsigned short b) { return __builtin_bit_cast(float, (unsigned)b << 16); }
__device__ __forceinline__ float bflo(unsigned w) { return __builtin_bit_cast(float, w << 16); }
__device__ __forceinline__ float bfhi(unsigned w) { return __builtin_bit_cast(float, w & 0xffff0000u); }
__device__ __forceinline__ int opq(int x) { asm volatile("" : "+v"(x)); return x; }
__device__ __forceinline__ float silu_f(float x) { return x * __frcp_rn(1.f + __expf(-x)); }

namespace pg8 {
constexpr int BM = 256, BK = 64, HALF = 128, HTB = HALF * BK * 2, STAGE_BYTES = 8 * HTB, NXCD = 8, WGM = 8;
__host__ __device__ __forceinline__ int lds_byte(int r, int c) { const int st = (r >> 4) * 2 + (c >> 5), rr = r & 15, cc = c & 31, ob = rr * 64 + cc * 2; return st * 1024 + (ob ^ (((ob >> 9) & 1) << 5)); }
__host__ __device__ __forceinline__ void stage_rc(int b, int& R, int& C) { const int st = b / 1024, sb = b % 1024, swz = sb ^ (((sb >> 9) & 1) << 5); R = (st >> 1) * 16 + swz / 64; C = (st & 1) * 32 + (swz % 64) / 2; }
__host__ __device__ __forceinline__ int perm32(int rho) { const int n = rho >> 4, i = rho & 15; return 8 * (i >> 2) + 4 * n + (i & 3); }

struct Unit { int pm, pn; };
struct Gemm { const bf16_t* A; const bf16_t* Bt; int M, N, K; };

struct StaticOrder {
    int nM, nN, nwg, G, c;
    __host__ __device__ void init(int M, int N, int G_, int c_) { nM = M / BM; nN = N / BM; nwg = nM * nN; G = G_; c = c_; }
    __host__ __device__ bool next(int i, Unit& u) const {
        const long L = (long)i * G + c; if (L >= nwg) return false;
        int wgid = (int)L; { const int q = nwg / NXCD, r = nwg % NXCD, xcd = wgid % NXCD, off = wgid / NXCD; wgid = (xcd < r ? xcd * (q + 1) : r * (q + 1) + (xcd - r) * q) + off; }
        const int nig = WGM * nN, gid = wgid / nig, fm = gid * WGM, gsz = (nM - fm) < WGM ? (nM - fm) : WGM;
        u.pm = fm + ((wgid % nig) % gsz); u.pn = (wgid % nig) / gsz; return true;
    }
    __device__ __forceinline__ void a_ready(const Unit&) const {}
    __device__ __forceinline__ void done(const Unit&) const {}
};

template <class Epi, class Sched>
__device__ __forceinline__ void gemm_phase(LAS unsigned char* lds, const Gemm g, const Sched& S, const Epi& E) {
    const int tid = opq((int)threadIdx.x), wid = __builtin_amdgcn_readfirstlane(tid >> 6), lane = tid & 63, wr = wid >> 2, wc = wid & 3, fr = lane & 15, fq = lane >> 4;
    const int K = g.K, nt = K / BK;
    unsigned voffA[2], voffB[2];
#pragma unroll
    for (int i = 0; i < 2; ++i) { int R, C; stage_rc(tid * 16 + i * 8192, R, C); const int Rb = Epi::PERM ? ((R & ~31) + perm32(R & 31)) : R;
        voffA[i] = (unsigned)(R * K + C) * 2u; voffB[i] = (unsigned)(Rb * K + C) * 2u; }
    const size_t kstep = (size_t)(BK * 2);
    const size_t hstep = (size_t)HALF * K * 2;
    const size_t tstep = 2 * hstep;
    const unsigned ldsw = (unsigned)wid * 1024u;
    const int aoff = lds_byte(wr * 64 + fr, fq * 8), boff = lds_byte(wc * 32 + fr, fq * 8);
#define PG8_SA(b, h) (((b) * 2 + (h)) * HTB)
#define PG8_SB(b, h) ((4 + (b) * 2 + (h)) * HTB)
#define PG8_STAGE(bufoff, gbase, voff) do { _Pragma("unroll") for (int _i = 0; _i < 2; ++_i) \
        __builtin_amdgcn_global_load_lds((const unsigned*)((const char*)(gbase) + (voff)[_i]), (LAS unsigned*)(lds + (bufoff) + ldsw + _i * 8192), 16, 0, 0); } while (0)
#define PG8_LDA(dst, b, h) do { _Pragma("unroll") for (int m = 0; m < 4; ++m) _Pragma("unroll") for (int k = 0; k < 2; ++k) dst[m][k] = *(const LAS bf16x8*)(lds + PG8_SA(b, h) + aoff + m * 2048 + k * 1024); } while (0)
#define PG8_LDB(dst, b, h) do { _Pragma("unroll") for (int n = 0; n < 2; ++n) _Pragma("unroll") for (int k = 0; k < 2; ++k) dst[n][k] = *(const LAS bf16x8*)(lds + PG8_SB(b, h) + boff + n * 2048 + k * 1024); } while (0)
#define PG8_MMA(ai, bj, At, Bt) do { __builtin_amdgcn_s_setprio(1); _Pragma("unroll") for (int m = 0; m < 4; ++m) _Pragma("unroll") for (int n = 0; n < 2; ++n) _Pragma("unroll") for (int k = 0; k < 2; ++k) \
        acc[ai][bj][m][n] = __builtin_amdgcn_mfma_f32_16x16x32_bf16(Bt[n][k], At[m][k], acc[ai][bj][m][n], 0, 0, 0); __builtin_amdgcn_s_setprio(0); } while (0)
#define PG8_WAIT_V(n) asm volatile("s_waitcnt vmcnt(" #n ")" ::: "memory")
#define PG8_WAIT_L(n) asm volatile("s_waitcnt lgkmcnt(" #n ")" ::: "memory")
#define PG8_BAR __builtin_amdgcn_s_barrier()
#define PG8_SCHED __builtin_amdgcn_sched_barrier(0)
    Unit cur, nxt; int ui = 0;
    if (!S.next(0, cur)) return;
    f32x4 acc[2][2][4][2];
#pragma unroll
    for (int a = 0; a < 2; ++a)
#pragma unroll
        for (int b = 0; b < 2; ++b)
#pragma unroll
            for (int m = 0; m < 4; ++m)
#pragma unroll
                for (int n = 0; n < 2; ++n) acc[a][b][m][n] = (f32x4){0.f, 0.f, 0.f, 0.f};
    bf16x8 At[4][2], B0[2][2], B1[2][2];
    const char* cA = (const char*)g.A + (size_t)cur.pm * tstep; const char* cB = (const char*)g.Bt + (size_t)cur.pn * tstep;
    S.a_ready(cur);
    PG8_STAGE(PG8_SB(0, 0), cB, voffB); PG8_STAGE(PG8_SB(0, 1), cB + hstep, voffB); PG8_STAGE(PG8_SA(0, 0), cA, voffA); PG8_STAGE(PG8_SA(0, 1), cA + hstep, voffA);
    if (wr == 1) PG8_BAR;
    PG8_WAIT_V(2); PG8_BAR;
    PG8_STAGE(PG8_SB(1, 0), cB + kstep, voffB); PG8_STAGE(PG8_SA(1, 0), cA + kstep, voffA); PG8_STAGE(PG8_SB(1, 1), cB + hstep + kstep, voffB);
    PG8_WAIT_V(6); PG8_BAR;
    for (;;) {
        const bool has_next = S.next(ui + 1, nxt);
        const char* nA = has_next ? (const char*)g.A + (size_t)nxt.pm * tstep : cA; const char* nB = has_next ? (const char*)g.Bt + (size_t)nxt.pn * tstep : cB;
        for (int t = 0; t < nt; t += 2) {
            const bool last = (t == nt - 2);
            const char* a1 = cA + (size_t)(t + 1) * kstep;
            const char* a2 = last ? nA : cA + (size_t)(t + 2) * kstep; const char* b2 = last ? nB : cB + (size_t)(t + 2) * kstep;
            const char* a3 = a2 + kstep; const char* b3 = b2 + kstep;
            if (last && has_next) S.a_ready(nxt);
            PG8_LDB(B0, 0, 0); PG8_LDB(B1, 0, 1); PG8_SCHED; PG8_LDA(At, 0, 0); PG8_STAGE(PG8_SA(1, 1), a1 + hstep, voffA);
            PG8_WAIT_V(8); PG8_WAIT_L(0); PG8_BAR; PG8_MMA(0, 0, At, B0); PG8_MMA(0, 1, At, B1); PG8_BAR; PG8_SCHED;
            PG8_LDA(At, 0, 1); PG8_STAGE(PG8_SB(0, 0), b2, voffB); PG8_STAGE(PG8_SB(0, 1), b2 + hstep, voffB); PG8_STAGE(PG8_SA(0, 0), a2, voffA);
            PG8_WAIT_V(8); PG8_WAIT_L(0); PG8_BAR; PG8_MMA(1, 0, At, B0); PG8_MMA(1, 1, At, B1); PG8_BAR; PG8_SCHED;
            PG8_LDB(B0, 1, 0); PG8_LDB(B1, 1, 1); PG8_SCHED; PG8_LDA(At, 1, 0); PG8_STAGE(PG8_SA(0, 1), a2 + hstep, voffA);
            PG8_WAIT_V(8); PG8_WAIT_L(0); PG8_BAR; PG8_MMA(0, 0, At, B0); PG8_MMA(0, 1, At, B1); PG8_BAR; PG8_SCHED;
            PG8_LDA(At, 1, 1); PG8_STAGE(PG8_SB(1, 0), b3, voffB); PG8_STAGE(PG8_SB(1, 1), b3 + hstep, voffB); PG8_STAGE(PG8_SA(1, 0), a3, voffA);
            PG8_WAIT_V(8); PG8_WAIT_L(0); PG8_BAR; PG8_MMA(1, 0, At, B0); PG8_MMA(1, 1, At, B1); PG8_BAR; PG8_SCHED;
        }
        if (wr == 0) PG8_BAR;
        E(acc, cur, wr, wc, fr, fq); S.done(cur);
        if (!has_next) break;
#pragma unroll
        for (int a = 0; a < 2; ++a)
#pragma unroll
            for (int b = 0; b < 2; ++b)
#pragma unroll
                for (int m = 0; m < 4; ++m)
#pragma unroll
                    for (int n = 0; n < 2; ++n) acc[a][b][m][n] = (f32x4){0.f, 0.f, 0.f, 0.f};
        cur = nxt; cA = nA; cB = nB; ++ui;
        if (wr == 1) PG8_BAR;
    }
    PG8_WAIT_V(0);
    PG8_BAR;
#undef PG8_SA
#undef PG8_SB
#undef PG8_STAGE
#undef PG8_LDA
#undef PG8_LDB
#undef PG8_MMA
#undef PG8_WAIT_V
#undef PG8_WAIT_L
#undef PG8_BAR
#undef PG8_SCHED
}
}

__device__ __forceinline__ u32x4 pack8(const f32x4 a, const f32x4 b) { u32x4 w; w.x = pk2(a[0], a[1]); w.y = pk2(a[2], a[3]); w.z = pk2(b[0], b[1]); w.w = pk2(b[2], b[3]); return w; }

struct EpiIn {
    static constexpr bool PERM = true;
    GAS unsigned char* ws; float* out; int l;
    __device__ __forceinline__ void operator()(const f32x4 (&acc)[2][2][4][2], const pg8::Unit& u, int wr, int wc, int fr, int fq) const {
        const int pn = u.pn, row0 = u.pm * 256 + wr * 64 + fr, cw = wc * 32 + 8 * fq;
        const float* const ssq = WSP(const float, WS_SSQ) + l * MPAD;
        if (pn < 4 || (pn >= 6 && pn < 14) || pn >= 18) {
            bf16_t* base; int mode; int cb;
            if (pn < 4) { base = WSP(bf16_t, WS_Q); mode = 0; cb = pn * 256; }
            else if (pn < 10) { base = WSP(bf16_t, WS_GA); mode = 1; cb = (pn - 6) * 256; }
            else if (pn < 14) { base = WSP(bf16_t, WS_QR); mode = 1; cb = (pn - 10) * 256; }
            else if (pn < 22) { base = WSP(bf16_t, WS_IR); mode = 2; cb = (pn - 18) * 256; }
            else { base = WSP(bf16_t, WS_GR); mode = 1; cb = (pn - 22) * 256; }
#pragma unroll
            for (int ai = 0; ai < 2; ++ai)
#pragma unroll
                for (int m = 0; m < 4; ++m) { const int row = row0 + ai * 128 + m * 16; const float rs = rsqrtf(ssq[row] * (1.f / 2048.f) + EPS);
#pragma unroll
                    for (int bj = 0; bj < 2; ++bj) { f32x4 v0 = acc[ai][bj][m][0] * rs, v1 = acc[ai][bj][m][1] * rs;
                        if (mode == 0) { v0 = v0 * 0.125f; v1 = v1 * 0.125f; }
                        else if (mode == 1) {
#pragma unroll
                            for (int e = 0; e < 4; ++e) { v0[e] = silu_f(v0[e]); v1[e] = silu_f(v1[e]); } }
                        *(u32x4*)(base + (size_t)row * 1024 + cb + cw + bj * 128) = pack8(v0, v1); } }
        } else if (pn < 6) {
            bf16_t* base = pn == 4 ? WSP(bf16_t, WS_KB) : WSP(bf16_t, WS_VB); float* pc = out + (pn == 4 ? O_PCK : O_PCV) + (size_t)l * NBATCH * WIN * 256; float* sc = out + (pn == 4 ? O_SCK : O_SCV) + (size_t)l * DBATCH * WIN * 256;
#pragma unroll
            for (int ai = 0; ai < 2; ++ai)
#pragma unroll
                for (int m = 0; m < 4; ++m) { const int row = row0 + ai * 128 + m * 16; const float rs = rsqrtf(ssq[row] * (1.f / 2048.f) + EPS);
                    float* dst = nullptr;
                    if (row < MPR) { const int b = row / LP, t = row - b * LP; if (t >= LP - WIN) dst = pc + ((size_t)(b * WIN + t - (LP - WIN))) * 256; }
                    else if (row < MTOT) { const int rr = row - MPR; dst = sc + ((size_t)((rr >> 3) * WIN + (WIN - DSEQ) + (rr & 7))) * 256; }
#pragma unroll
                    for (int bj = 0; bj < 2; ++bj) { const f32x4 v0 = acc[ai][bj][m][0] * rs, v1 = acc[ai][bj][m][1] * rs; const int c = cw + bj * 128;
                        *(u32x4*)(base + (size_t)row * 256 + c) = pack8(v0, v1);
                        if (dst) { *(f32x4*)(dst + c) = v0; *(f32x4*)(dst + c + 4) = v1; } } }
        } else {
            const int cb = (pn - 14) * 256; const float* const lb = WSP(const float, WS_LB) + l * 1024; float* const LOGF = WSP(float, WS_LOGF); bf16_t* const KR = WSP(bf16_t, WS_KR);
            f32x4 l0[2], l1[2];
#pragma unroll
            for (int bj = 0; bj < 2; ++bj) { l0[bj] = *(const f32x4*)(lb + cb + cw + bj * 128); l1[bj] = *(const f32x4*)(lb + cb + cw + bj * 128 + 4); }
#pragma unroll
            for (int ai = 0; ai < 2; ++ai)
#pragma unroll
                for (int m = 0; m < 4; ++m) { const int row = row0 + ai * 128 + m * 16; const float rs = rsqrtf(ssq[row] * (1.f / 2048.f) + EPS);
#pragma unroll
                    for (int bj = 0; bj < 2; ++bj) { const f32x4 x0 = acc[ai][bj][m][0] * rs, x1 = acc[ai][bj][m][1] * rs; f32x4 f0, f1, k0, k1;
#pragma unroll
                        for (int e = 0; e < 4; ++e) {
                            { const float x = x0[e], lbv = l0[bj][e], sp = __frcp_rn(1.f + __expf(-x)), sn = __frcp_rn(1.f + __expf(x)); f0[e] = fmaxf(__logf(lbv + (1.f - lbv) * sp), -80.f); k0[e] = (1.f - lbv) * sn; }
                            { const float x = x1[e], lbv = l1[bj][e], sp = __frcp_rn(1.f + __expf(-x)), sn = __frcp_rn(1.f + __expf(x)); f1[e] = fmaxf(__logf(lbv + (1.f - lbv) * sp), -80.f); k1[e] = (1.f - lbv) * sn; } }
                        const size_t o = (size_t)row * 1024 + cb + cw + bj * 128;
                        *(f32x4*)(LOGF + o) = f0; *(f32x4*)(LOGF + o + 4) = f1; *(u32x4*)(KR + o) = pack8(k0, k1); } }
        }
    }
};

struct EpiOut {
    static constexpr bool PERM = true;
    GAS unsigned char* ws; int l;
    __device__ __forceinline__ void operator()(const f32x4 (&acc)[2][2][4][2], const pg8::Unit& u, int wr, int wc, int fr, int fq) const {
        const int row0 = u.pm * 256 + wr * 64 + fr, c0 = u.pn * 256 + wc * 32 + 8 * fq;
        bf16_t* const HB = WSP(bf16_t, WS_HB); float* const ssq_next = WSP(float, WS_SSQ) + (l + 1) * MPAD;
#pragma unroll
        for (int ai = 0; ai < 2; ++ai)
#pragma unroll
            for (int m = 0; m < 4; ++m) { const int row = row0 + ai * 128 + m * 16; float s = 0.f;
#pragma unroll
                for (int bj = 0; bj < 2; ++bj) { bf16_t* hp = HB + (size_t)row * DM + c0 + bj * 128; const u32x4 hv = *(const u32x4*)hp;
                    const f32x4 h0 = (f32x4){bflo(hv.x), bfhi(hv.x), bflo(hv.y), bfhi(hv.y)} + acc[ai][bj][m][0], h1 = (f32x4){bflo(hv.z), bfhi(hv.z), bflo(hv.w), bfhi(hv.w)} + acc[ai][bj][m][1];
                    *(u32x4*)hp = pack8(h0, h1);
                    s += (h0[0] * h0[0] + h0[1] * h0[1]) + (h0[2] * h0[2] + h0[3] * h0[3]) + (h1[0] * h1[0] + h1[1] * h1[1]) + (h1[2] * h1[2] + h1[3] * h1[3]); }
                s += __shfl_xor(s, 16); s += __shfl_xor(s, 32);
                if (fq == 0) __hip_atomic_fetch_add(ssq_next + row, s, __ATOMIC_RELAXED, __HIP_MEMORY_SCOPE_AGENT);
                asm volatile("" ::: "memory"); }
    }
};

#define XB_TMO      128
#define XB_XCNT(j)  (256  + 64 * (j))
#define XB_XSUB(j)  (1280 + 64 * (j))
#define XB_XGEN(j)  (2304 + 64 * (j))
#define XB_TOP      3328
#define XB_TOPGEN   3392
#define XCD_BAR_WORDS 3456
#define XB_SPIN_CAP (1u << 20)
__device__ __forceinline__ unsigned xb_ld(unsigned* p)              { return __hip_atomic_load(p, __ATOMIC_RELAXED, __HIP_MEMORY_SCOPE_AGENT); }
__device__ __forceinline__ unsigned xb_add(unsigned* p, unsigned v) { return __hip_atomic_fetch_add(p, v, __ATOMIC_RELAXED, __HIP_MEMORY_SCOPE_AGENT); }
__device__ __forceinline__ unsigned xb_xcc_id() { return (unsigned)__builtin_amdgcn_s_getreg((3 << 11) | 20) & 0xFu; }
#define XB_SPIN(cond, bar) do { unsigned _sp = 0; while (cond) { __builtin_amdgcn_s_sleep(1); \
    if ((++_sp & 255u) == 0u) { if (xb_ld(&(bar)[XB_TMO])) break; if (_sp > XB_SPIN_CAP) { atomicAdd(&(bar)[XB_TMO], 1u); break; } } } } while (0)
struct XcdBarrier { unsigned* bar; unsigned x; volatile LAS unsigned* st; };
__device__ __forceinline__ XcdBarrier xcd_barrier_post(unsigned* bar, volatile LAS unsigned* st) {
    XcdBarrier b; b.bar = bar; b.x = xb_xcc_id(); b.st = st;
    if (threadIdx.x == 0) (void)xb_add(&bar[XB_XCNT(b.x)], 1u);
    return b;
}
__device__ __forceinline__ void xcd_barrier_complete(unsigned* bar, unsigned x, unsigned& nloc, unsigned& nx) {
    const unsigned G = gridDim.x * gridDim.y * gridDim.z;
    unsigned sum, cnt, mine, sp = 0u;
    for (;;) {
        sum = 0u; cnt = 0u; mine = 0u;
#pragma unroll
        for (unsigned j = 0; j < 16; ++j) { const unsigned c = xb_ld(&bar[XB_XCNT(j)]); sum += c; cnt += (c > 0u) ? 1u : 0u; mine = (j == x) ? c : mine; }
        if (sum == G) break;
        __builtin_amdgcn_s_sleep(1);
        if ((++sp & 255u) == 0u) { if (xb_ld(&bar[XB_TMO])) break; if (sp > XB_SPIN_CAP) { atomicAdd(&bar[XB_TMO], 1u); break; } }
    }
    nloc = mine > 0u ? mine : 1u; nx = cnt > 0u ? cnt : 1u;
}
__device__ __forceinline__ void xcd_barrier(const XcdBarrier& b) {
    asm volatile("s_waitcnt vmcnt(0)" ::: "memory");
    __syncthreads();
    if (threadIdx.x == 0) {
        unsigned* bar = b.bar;
        __builtin_amdgcn_s_waitcnt(0);
        unsigned nloc = b.st[0], nx = b.st[1];
        if (nloc == 0u) { xcd_barrier_complete(bar, b.x, nloc, nx); b.st[0] = nloc; b.st[1] = nx; }
        const unsigned old = xb_add(&bar[XB_XSUB(b.x)], 1u);
        const unsigned gen = old / nloc;
        if (old + 1u == (gen + 1u) * nloc) {
            __builtin_amdgcn_fence(__ATOMIC_RELEASE, "agent");
            asm volatile("s_waitcnt vmcnt(0)" ::: "memory");
            const unsigned og = xb_add(&bar[XB_TOP], 1u);
            const unsigned tg = og / nx;
            if (og + 1u == (tg + 1u) * nx) xb_add(&bar[XB_TOPGEN], 1u);
            else XB_SPIN(xb_ld(&bar[XB_TOPGEN]) == tg, bar);
            __builtin_amdgcn_fence(__ATOMIC_ACQUIRE, "agent");
            xb_add(&bar[XB_XGEN(b.x)], 1u);
            asm volatile("s_waitcnt vmcnt(0)" ::: "memory");
        } else {
            XB_SPIN(xb_ld(&bar[XB_XGEN(b.x)]) == gen, bar);
            __builtin_amdgcn_fence(__ATOMIC_ACQUIRE, "agent");
            asm volatile("s_waitcnt vmcnt(0)" ::: "memory");
        }
    }
    __syncthreads();
}

struct Args { const float* in[14]; float* out; unsigned char* ws; int ph_lo, ph_hi; };
struct Frame {
    LAS unsigned char* lds;
    int tid, lane, wave, G, bid;
};
constexpr int PT_OFF = LDS_BYTES - 512;
__device__ __forceinline__ unsigned long long ptab(const Frame& F, int i) {
    volatile LAS unsigned* t = (volatile LAS unsigned*)(F.lds + PT_OFF) + 2 * i;
    const unsigned lo = __builtin_amdgcn_readfirstlane(t[0]), hi = __builtin_amdgcn_readfirstlane(t[1]);
    return ((unsigned long long)hi << 32) | lo;
}
#define INP(i) ((const float*)(const GAS float*)ptab(F, (i)))
#define OUTP() ((float*)(GAS float*)ptab(F, 14))
#define WSB() ((GAS unsigned char*)ptab(F, 15))
enum { I_XP = 0, I_XS = 1, I_CK = 2, I_CV = 3, I_ST = 4, I_META = 5, I_WIN = 6, I_WOUT = 7, I_NW = 8, I_FW = 9, I_SINK = 10, I_RB = 11, I_LBL = 12, I_HNW = 13 };

__device__ __forceinline__ float wave_sum(float v) {
#pragma unroll
    for (int o = 1; o < 64; o <<= 1) v += __shfl_xor(v, o);
    return v;
}

__device__ __forceinline__ int t5_bucket(int d) {
    if (d < 16) return d;
    const float v = __logf((float)d * (1.f / 16.f)) / 2.0794415416798357f * 16.f;
    int b = 16 + (int)v; return b > 31 ? 31 : b;
}

__device__ __forceinline__ void conv_item(Frame& F, const float* W, int K, int N, bf16_t* WT, const float* sc, int item) {
    const int tid = opq(F.tid), lane = tid & 63, w = tid >> 6; LAS float* T = (LAS float*)F.lds;
    const int nblk = N / 128, kb = item / nblk, nb = item % nblk, k0 = kb * 128, n0 = nb * 128;
    f32x4 v[8];
#pragma unroll
    for (int p = 0; p < 8; ++p) { const int row = p * 16 + w * 2 + (lane >> 5); v[p] = *(const f32x4*)(W + (size_t)(k0 + row) * N + n0 + (lane & 31) * 4); }
#pragma unroll
    for (int p = 0; p < 8; ++p) { const int row = p * 16 + w * 2 + (lane >> 5); const float s = sc ? sc[k0 + row] : 1.f; LAS float* d = T + row * 129 + (lane & 31) * 4;
        d[0] = v[p][0] * s; d[1] = v[p][1] * s; d[2] = v[p][2] * s; d[3] = v[p][3] * s; }
    __syncthreads();
#pragma unroll
    for (int j = 0; j < 4; ++j) { const int o = tid + NTHR * j, kg = o & 15, n = o >> 4; const LAS float* s = T + (kg * 8) * 129 + n;
        u32x4 ov; ov.x = pk2(s[0], s[129]); ov.y = pk2(s[2 * 129], s[3 * 129]); ov.z = pk2(s[4 * 129], s[5 * 129]); ov.w = pk2(s[6 * 129], s[7 * 129]);
        *(u32x4*)(WT + (size_t)(n0 + n) * K + k0 + kg * 8) = ov; }
    __syncthreads();
}
constexpr int CI_IN = (DM / 128) * (DIN / 128), CI_OUT = (DM / 128) * (DM / 128), CI_LAYER = CI_IN + CI_OUT;
__device__ __forceinline__ void conv_layer(Frame& F, int l, int first, int stride) {
    GAS unsigned char* const ws = WSB();
    const float* const in_w_in = INP(I_WIN); const float* const in_w_out = INP(I_WOUT); const float* const in_norm_w = INP(I_NW);
#pragma unroll 1
    for (int it = first; it < CI_LAYER; it += stride) {
        if (it < CI_IN) conv_item(F, in_w_in + (size_t)l * DM * DIN, DM, DIN, WSP(bf16_t, WS_WIN) + (size_t)l * DIN * DM, in_norm_w + l * DM, it);
        else conv_item(F, in_w_out + (size_t)l * DM * DM, DM, DM, WSP(bf16_t, WS_WOUT) + (size_t)l * DM * DM, nullptr, it - CI_IN);
    }
}

__device__ __forceinline__ void phase_prologue(Frame& F) {
    conv_layer(F, 0, F.bid, F.G);
    GAS unsigned char* const ws = WSB(); float* const out = OUTP();
    const int gw = F.bid * NWAVES + F.wave, NGW = F.G * NWAVES;
    const float* const in_meta = INP(I_META); const float* const in_x_prompt = INP(I_XP); const float* const in_x_sample = INP(I_XS);
    for (int row = gw; row < MPAD; row += NGW) {
        const float* src = nullptr;
        if (row < MPR) { const int b = row / LP, t = row - b * LP; src = t < NMETA ? in_meta + (size_t)t * DM : in_x_prompt + ((size_t)b * SEQ + (t - NMETA)) * DM; }
        else if (row < MTOT) src = in_x_sample + (size_t)(row - MPR) * DM;
        float s = 0.f;
#pragma unroll
        for (int j = 0; j < 8; ++j) { const int c = (F.lane + 64 * j) * 4; f32x4 v = src ? *(const f32x4*)(src + c) : (f32x4){0.f, 0.f, 0.f, 0.f};
            u32x2 w; w.x = pk2(v[0], v[1]); w.y = pk2(v[2], v[3]); *(u32x2*)(WSP(bf16_t, WS_HB) + (size_t)row * DM + c) = w;
            s += (v[0] * v[0] + v[1] * v[1]) + (v[2] * v[2] + v[3] * v[3]); }
        s = wave_sum(s);
        if (F.lane == 0) WSP(float, WS_SSQ)[row] = s;
    }
    const int gt = F.bid * NTHR + F.tid, NGT = F.G * NTHR;
    const float* const in_lb_logits = INP(I_LBL); const float* const in_rel_bias = INP(I_RB); const float* const in_cache_k = INP(I_CK); const float* const in_cache_v = INP(I_CV);
    for (int c = gt; c < 1024; c += NGT) {
        float v[4], mx = -INFINITY;
#pragma unroll
        for (int l = 0; l < 4; ++l) { v[l] = in_lb_logits[l * 1024 + c]; mx = fmaxf(mx, v[l]); }
        float sum = 0.f;
#pragma unroll
        for (int l = 0; l < 4; ++l) { v[l] = expf(v[l] - mx); sum += v[l]; }
        float cum = 0.f; const float p0 = v[0] / sum;
#pragma unroll
        for (int l = 0; l < 4; ++l) { cum += v[l] / sum; WSP(float, WS_LB)[l * 1024 + c] = cum - p0; }
    }
    for (int i = gt; i < 16 * 128; i += NGT) { const int h = i >> 7, d = i & 127; WSP(float, WS_BIAS)[i] = in_rel_bias[t5_bucket(d) * 16 + h]; }
    { constexpr int PERLB = (WIN - DSEQ) * 256 / 4;
      constexpr int TOT = DEPTH * DBATCH * PERLB;
      for (int i = gt; i < TOT; i += NGT) { const int lbi = i / PERLB, r = i % PERLB; const size_t so = (size_t)lbi * WIN * 256 + (size_t)DSEQ * 256 + (size_t)r * 4, dofs = (size_t)lbi * WIN * 256 + (size_t)r * 4;
          *(f32x4*)(out + O_SCK + dofs) = *(const f32x4*)(in_cache_k + so); *(f32x4*)(out + O_SCV + dofs) = *(const f32x4*)(in_cache_v + so); } }
}

__device__ __forceinline__ bf16x8 ldfrag(const LAS unsigned char* base, int row, int stride_b, int kelem) { return *(const LAS bf16x8*)(base + row * stride_b + kelem * 2); }
#define MMA16(acc, nfrag, mfrag) acc = __builtin_amdgcn_mfma_f32_16x16x32_bf16(nfrag, mfrag, acc, 0, 0, 0)

constexpr int AT_QS = 0, AT_KS = 18432, AT_VT = 41472, AT_PS = 62976, AT_BT = 105984;
template <bool SAMPLE>
__device__ __forceinline__ void attn_unit(Frame& F, int l, int unit, int nqcap = 32) {
    const int tid = opq(F.tid), lane = tid & 63, w = F.wave, fr = lane & 15, fq = lane >> 4;
    LAS unsigned char* lds = F.lds;
    int b, kvh, p0, nq, rowbase;
    GAS unsigned char* const ws = WSB(); const float* const in_cache_k = INP(I_CK); const float* const in_cache_v = INP(I_CV); const float* const in_sinks = INP(I_SINK);
    constexpr int QH = SAMPLE ? 8 : 32, NR = SAMPLE ? 32 : 128;
    if (SAMPLE) { b = unit >> 2; kvh = unit & 3; p0 = 0; nq = 8; rowbase = MPR + b * DSEQ; }
    else { const int bk = unit / 65, blk = unit % 65; b = bk >> 2; kvh = bk & 3; p0 = blk * 32; nq = (LP - p0) < nqcap ? (LP - p0) : nqcap; rowbase = b * LP; }
    const int kbase = p0 - WIN;
#pragma unroll
    for (int r = 0; r < 2; ++r) { const int q = tid + NTHR * r, row = q >> 3, c8 = q & 7; u32x4 v = (u32x4){0u, 0u, 0u, 0u};
        if (row < NR) { const int hl = row / QH, qi = row % QH; if (qi < nq) v = *(const u32x4*)(WSP(bf16_t, WS_Q) + (size_t)(rowbase + p0 + qi) * 1024 + (kvh * 4 + hl) * 64 + c8 * 8); }
        *(LAS u32x4*)(lds + AT_QS + row * 144 + c8 * 16) = v; }
#pragma unroll
    for (int r = 0; r < 3; ++r) { const int q = tid + NTHR * r; if (q < 1280) { const int j = q >> 3, c8 = q & 7, kp = kbase + j; u32x4 v = (u32x4){0u, 0u, 0u, 0u};
        if (SAMPLE) {
            if (j < WIN) { const float* src = in_cache_k + ((((size_t)l * DBATCH + b) * WIN + j) * 4 + kvh) * 64 + c8 * 8; const f32x4 a = *(const f32x4*)src, c = *(const f32x4*)(src + 4); v = pack8(a, c); }
            else if (j < WIN + DSEQ) v = *(const u32x4*)(WSP(bf16_t, WS_KB) + (size_t)(rowbase + j - WIN) * 256 + kvh * 64 + c8 * 8);
        } else { if (kp >= 0 && kp < LP) v = *(const u32x4*)(WSP(bf16_t, WS_KB) + (size_t)(rowbase + kp) * 256 + kvh * 64 + c8 * 8); }
        *(LAS u32x4*)(lds + AT_KS + j * 144 + c8 * 16) = v; } }
#pragma unroll
    for (int r = 0; r < 3; ++r) { const int q = tid + NTHR * r; if (q < 1280) { const int j = q % 160, c8 = q / 160, kp = kbase + j; u32x4 v = (u32x4){0u, 0u, 0u, 0u};
        if (SAMPLE) {
            if (j < WIN) { const float* src = in_cache_v + ((((size_t)l * DBATCH + b) * WIN + j) * 4 + kvh) * 64 + c8 * 8; const f32x4 a = *(const f32x4*)src, c = *(const f32x4*)(src + 4); v = pack8(a, c); }
            else if (j < WIN + DSEQ) v = *(const u32x4*)(WSP(bf16_t, WS_VB) + (size_t)(rowbase + j - WIN) * 256 + kvh * 64 + c8 * 8);
        } else { if (kp >= 0 && kp < LP) v = *(const u32x4*)(WSP(bf16_t, WS_VB) + (size_t)(rowbase + kp) * 256 + kvh * 64 + c8 * 8); }
        LAS unsigned short* vt = (LAS unsigned short*)(lds + AT_VT) + (c8 * 8) * 168 + j;
        vt[0 * 168] = (unsigned short)(v.x & 0xffffu); vt[1 * 168] = (unsigned short)(v.x >> 16); vt[2 * 168] = (unsigned short)(v.y & 0xffffu); vt[3 * 168] = (unsigned short)(v.y >> 16);
        vt[4 * 168] = (unsigned short)(v.z & 0xffffu); vt[5 * 168] = (unsigned short)(v.z >> 16); vt[6 * 168] = (unsigned short)(v.w & 0xffffu); vt[7 * 168] = (unsigned short)(v.w >> 16); } }
    ((LAS float*)(lds + AT_BT))[tid] = WSP(float, WS_BIAS)[(kvh * 4 + (tid >> 7)) * 128 + (tid & 127)];
    __syncthreads();
    if (w * 16 < NR) {
        f32x4 acc[10];
#pragma unroll
        for (int n = 0; n < 10; ++n) acc[n] = (f32x4){0.f, 0.f, 0.f, 0.f};
#pragma unroll
        for (int ks = 0; ks < 2; ++ks) { const bf16x8 mf = ldfrag(lds + AT_QS, w * 16 + fr, 144, ks * 32 + fq * 8);
#pragma unroll
            for (int n = 0; n < 10; ++n) { const bf16x8 nf = ldfrag(lds + AT_KS, n * 16 + fr, 144, ks * 32 + fq * 8); MMA16(acc[n], nf, mf); } }
        const int r = w * 16 + fr, hl = r / QH, qi = r % QH, p = p0 + qi;
        const bool rowok = qi < nq;
        const LAS float* bt = (const LAS float*)(lds + AT_BT) + hl * 128;
        const int kmin = SAMPLE ? -WIN : 0;
        float mx = -INFINITY;
#pragma unroll
        for (int n = 0; n < 10; ++n)
#pragma unroll
            for (int e = 0; e < 4; ++e) { const int kp = kbase + n * 16 + fq * 4 + e, dist = p - kp; const bool ok = rowok && dist >= 0 && dist < WIN && kp >= kmin;
                const float s = ok ? acc[n][e] + bt[dist & 127] : -INFINITY; acc[n][e] = s; mx = fmaxf(mx, s); }
        mx = fmaxf(mx, __shfl_xor(mx, 16)); mx = fmaxf(mx, __shfl_xor(mx, 32));
        const float sink = in_sinks[l * 16 + kvh * 4 + hl];
        const float mm = fmaxf(mx, sink);
        float sum = 0.f;
#pragma unroll
        for (int n = 0; n < 10; ++n)
#pragma unroll
            for (int e = 0; e < 4; ++e) { const float ev = __expf(acc[n][e] - mm); acc[n][e] = ev; sum += ev; }
        sum += __shfl_xor(sum, 16); sum += __shfl_xor(sum, 32);
        const float inv = 1.f / (sum + __expf(sink - mm));
#pragma unroll
        for (int n = 0; n < 10; ++n) { u32x2 pw; pw.x = pk2(acc[n][0] * inv, acc[n][1] * inv); pw.y = pk2(acc[n][2] * inv, acc[n][3] * inv);
            *(LAS u32x2*)(lds + AT_PS + r * 336 + (n * 16 + fq * 4) * 2) = pw; }
        LDS_WAIT(); asm volatile("" ::: "memory");
        f32x4 o[4];
#pragma unroll
        for (int n = 0; n < 4; ++n) o[n] = (f32x4){0.f, 0.f, 0.f, 0.f};
#pragma unroll
        for (int ks = 0; ks < 5; ++ks) { const bf16x8 mf = ldfrag(lds + AT_PS, r, 336, ks * 32 + fq * 8);
#pragma unroll
            for (int n = 0; n < 4; ++n) { const bf16x8 nf = ldfrag(lds + AT_VT, n * 16 + fr, 336, ks * 32 + fq * 8); MMA16(o[n], nf, mf); } }
        if (rowok) { const size_t grow = (size_t)(rowbase + p); const int hc = (kvh * 4 + hl) * 64;
#pragma unroll
            for (int n = 0; n < 4; ++n) { const int d = n * 16 + fq * 4; const u32x2 g = *(const u32x2*)(WSP(bf16_t, WS_GA) + grow * 1024 + hc + d);
                u32x2 yw; yw.x = pk2(o[n][0] * bflo(g.x), o[n][1] * bfhi(g.x)); yw.y = pk2(o[n][2] * bflo(g.y), o[n][3] * bfhi(g.y));
                *(u32x2*)(WSP(bf16_t, WS_Y) + grow * DM + hc + d) = yw; } }
    }
    __syncthreads();
}

constexpr int HS_F = 0, HS_K = 4096, HS_Q = 8192, HS_OP = 12288  , HS_O = 28672  ;
__device__ __forceinline__ void hgrn_sample_unit(Frame& F, int l, int unit) {
    const int tid = opq(F.tid), lane = tid & 63, w = F.wave; LAS unsigned char* lds = F.lds;
    GAS unsigned char* const ws = WSB(); float* const out = OUTP(); const float* const in_state_h = INP(I_ST); const float* const in_hnorm_w = INP(I_HNW);
    const int b = unit >> 3, h = unit & 7, dv = tid & 127, qd = tid >> 7, rowbase = MPR + b * DSEQ;
    const size_t sbase = ((((size_t)l * DBATCH + b) * 8 + h) * 128) * 128;
    float S[32];
#pragma unroll
    for (int i = 0; i < 32; ++i) S[i] = in_state_h[sbase + (size_t)(qd * 32 + i) * 128 + dv];
#pragma unroll
    for (int r = 0; r < 2; ++r) { const int e = tid + NTHR * r, t = e >> 7, d = e & 127; const size_t o = (size_t)(rowbase + t) * 1024 + h * 128 + d;
        ((LAS float*)(lds + HS_F))[e] = __expf(WSP(float, WS_LOGF)[o]); ((LAS float*)(lds + HS_K))[e] = bf2f(WSP(bf16_t, WS_KR)[o]); ((LAS float*)(lds + HS_Q))[e] = bf2f(WSP(bf16_t, WS_QR)[o]); }
    float vv[8];
#pragma unroll
    for (int t = 0; t < 8; ++t) vv[t] = bf2f(WSP(bf16_t, WS_IR)[(size_t)(rowbase + t) * 1024 + h * 128 + dv]);
    __syncthreads();
#pragma unroll
    for (int t = 0; t < 8; ++t) { const LAS float* fp = (const LAS float*)(lds + HS_F) + t * 128 + qd * 32; const LAS float* kp = (const LAS float*)(lds + HS_K) + t * 128 + qd * 32; const LAS float* qp = (const LAS float*)(lds + HS_Q) + t * 128 + qd * 32;
        float part = 0.f;
#pragma unroll
        for (int i = 0; i < 32; ++i) { S[i] = fp[i] * S[i] + kp[i] * vv[t]; part += S[i] * qp[i]; }
        ((LAS float*)(lds + HS_OP))[(t * 4 + qd) * 128 + dv] = part; }
#pragma unroll
    for (int i = 0; i < 32; ++i) out[O_SSH + sbase + (size_t)(qd * 32 + i) * 128 + dv] = S[i];
    __syncthreads();
    { const int t = w; const LAS float* op = (const LAS float*)(lds + HS_OP) + t * 512;
      const float o0 = op[lane] + op[128 + lane] + op[256 + lane] + op[384 + lane], o1 = op[64 + lane] + op[192 + lane] + op[320 + lane] + op[448 + lane];
      const float ss = wave_sum(o0 * o0 + o1 * o1), rn = rsqrtf(ss * (1.f / 128.f) + EPS);
      const size_t row = (size_t)(rowbase + t); const int c0 = h * 128 + lane, c1 = c0 + 64;
      const float y0 = o0 * rn * in_hnorm_w[l * 1024 + c0] * bf2f(WSP(bf16_t, WS_GR)[row * 1024 + c0]), y1 = o1 * rn * in_hnorm_w[l * 1024 + c1] * bf2f(WSP(bf16_t, WS_GR)[row * 1024 + c1]);
      WSP(bf16_t, WS_Y)[row * DM + 1024 + c0] = (bf16_t)f2bf(y0); WSP(bf16_t, WS_Y)[row * DM + 1024 + c1] = (bf16_t)f2bf(y1); }
    __syncthreads();
}

constexpr int HC_A = 0, HC_ASTR = 132, HC_TOT = 33792  , HC_END = 35840;
__device__ __forceinline__ void chunk_cumsum(Frame& F, int b, int h, int c) {
    const int tid = opq(F.tid); LAS float* A = (LAS float*)(F.lds + HC_A); LAS float* TOT = (LAS float*)(F.lds + HC_TOT);
    GAS unsigned char* const ws = WSB();
#pragma unroll
    for (int r = 0; r < 4; ++r) { const int q = tid + NTHR * r, i = q >> 5, c4 = q & 31, t = 64 * c - 48 + i; f32x4 v = (f32x4){0.f, 0.f, 0.f, 0.f};
        if (t >= 0) v = *(const f32x4*)(WSP(float, WS_LOGF) + (size_t)(b * LP + t) * 1024 + h * 128 + c4 * 4);
        *(LAS f32x4*)(A + i * HC_ASTR + c4 * 4) = v; }
    __syncthreads();
    const int d = tid & 127, sg = tid >> 7; float v[16]; float run = 0.f;
#pragma unroll
    for (int i = 0; i < 16; ++i) { run += A[(sg * 16 + i) * HC_ASTR + d]; v[i] = run; }
    TOT[sg * 128 + d] = run;
    __syncthreads();
    float off = 0.f;
#pragma unroll
    for (int s = 0; s < 3; ++s) if (s < sg) off += TOT[s * 128 + d];
#pragma unroll
    for (int i = 0; i < 16; ++i) A[(sg * 16 + i) * HC_ASTR + d] = v[i] + off;
    __syncthreads();
}
template <int MODE  >
__device__ __forceinline__ void chunk_transpose(Frame& F, const bf16_t* src, int b, int h, int c, int dst_off) {
    const int tid = opq(F.tid), i = tid & 63, t = 64 * c - 48 + i; const LAS float* A = (const LAS float*)(F.lds + HC_A);
#pragma unroll
    for (int r = 0; r < 2; ++r) { const int c8 = (tid >> 6) + 8 * r; u32x4 v = (u32x4){0u, 0u, 0u, 0u};
        if (t >= 0) v = *(const u32x4*)(src + (size_t)(b * LP + t) * 1024 + h * 128 + c8 * 8);
        float x[8] = {bflo(v.x), bfhi(v.x), bflo(v.y), bfhi(v.y), bflo(v.z), bfhi(v.z), bflo(v.w), bfhi(v.w)};
        LAS unsigned short* dst = (LAS unsigned short*)(F.lds + dst_off) + (c8 * 8) * 72 + i;
#pragma unroll
        for (int e = 0; e < 8; ++e) { float y = x[e]; if (MODE == 1) y *= __expf(A[63 * HC_ASTR + c8 * 8 + e] - A[i * HC_ASTR + c8 * 8 + e]); dst[e * 72] = (unsigned short)f2bf(y); } }
}

constexpr int HA_KT = HC_END, HA_VT = HA_KT + 18432;
__device__ __forceinline__ void hgrn_passA_unit(Frame& F, int uid) {
    GAS unsigned char* const ws = WSB();
    const int bh = uid / NCH, c = uid % NCH, b = bh >> 3, h = bh & 7, tid = opq(F.tid), lane = tid & 63, w = F.wave, fr = lane & 15, fq = lane >> 4; LAS unsigned char* lds = F.lds;
    chunk_cumsum(F, b, h, c);
    chunk_transpose<1>(F, WSP(bf16_t, WS_KR), b, h, c, HA_KT);
    chunk_transpose<0>(F, WSP(bf16_t, WS_IR), b, h, c, HA_VT);
    if (tid < 128) WSP(float, WS_GD)[(size_t)uid * 128 + tid] = __expf(((const LAS float*)(lds + HC_A))[63 * HC_ASTR + tid]);
    __syncthreads();
    f32x4 acc[8];
#pragma unroll
    for (int n = 0; n < 8; ++n) acc[n] = (f32x4){0.f, 0.f, 0.f, 0.f};
#pragma unroll
    for (int ks = 0; ks < 2; ++ks) { const bf16x8 mf = ldfrag(lds + HA_VT, w * 16 + fr, 144, ks * 32 + fq * 8);
#pragma unroll
        for (int n = 0; n < 8; ++n) { const bf16x8 nf = ldfrag(lds + HA_KT, n * 16 + fr, 144, ks * 32 + fq * 8); MMA16(acc[n], nf, mf); } }
    float* ut = WSP(float, WS_UT) + (size_t)uid * 16384 + (size_t)(w * 16 + fr) * 128;
#pragma unroll
    for (int n = 0; n < 8; ++n) *(f32x4*)(ut + n * 16 + fq * 4) = acc[n];
    __syncthreads();
}

__device__ __forceinline__ void hgrn_scan_unit(Frame& F, int l, int unit) {
    GAS unsigned char* const ws = WSB(); float* const out = OUTP();
    const int bh = unit >> 3, sl = unit & 7, tid = opq(F.tid), dvr = sl * 16 + (tid >> 5), dk = (tid & 31) * 4;
    f32x4 S = (f32x4){0.f, 0.f, 0.f, 0.f};
#pragma unroll 1
    for (int cb = 0; cb < NCH; cb += 11) {
        f32x4 ub[11], gb[11];
#pragma unroll
        for (int j = 0; j < 11; ++j) { const size_t uid = (size_t)bh * NCH + cb + j; ub[j] = *(const f32x4*)(WSP(float, WS_UT) + uid * 16384 + (size_t)dvr * 128 + dk); gb[j] = *(const f32x4*)(WSP(float, WS_GD) + uid * 128 + dk); }
#pragma unroll
        for (int j = 0; j < 11; ++j) { const size_t uid = (size_t)bh * NCH + cb + j; u32x2 sw; sw.x = pk2(S[0], S[1]); sw.y = pk2(S[2], S[3]);
            *(u32x2*)(WSP(bf16_t, WS_STB) + uid * 16384 + (size_t)dvr * 128 + dk) = sw; S = gb[j] * S + ub[j]; }
    }
    float* o = out + O_PSH + (((size_t)l * NBATCH * 8 + bh) * 128) * 128;
#pragma unroll
    for (int e = 0; e < 4; ++e) o[(size_t)(dk + e) * 128 + dvr] = S[e];
}

constexpr int HCc_QT = HC_END, HCc_KH = HCc_QT + 17408, HCc_VT = HCc_KH + 17408, HCc_SP = HCc_VT + 18432, HCc_PS = HCc_SP + 34816, HCc_RED = HCc_PS + 9216, HCc_END = HCc_RED + 512;
static_assert(HCc_END <= LDS_BYTES - 512, "pass C LDS");
__device__ __forceinline__ void hgrn_passC_unit(Frame& F, int l, int uid) {
    GAS unsigned char* const ws = WSB(); const float* const in_hnorm_w = INP(I_HNW);
    const int bh = uid / NCH, c = uid % NCH, b = bh >> 3, h = bh & 7, tid = opq(F.tid), lane = tid & 63, w = F.wave, fr = lane & 15, fq = lane >> 4; LAS unsigned char* lds = F.lds;
    chunk_cumsum(F, b, h, c);
    const LAS float* A = (const LAS float*)(lds + HC_A);
#pragma unroll
    for (int r = 0; r < 2; ++r) { const int q = tid + NTHR * r, i = q >> 4, c8 = q & 15, t = 64 * c - 48 + i; u32x4 qv = (u32x4){0u, 0u, 0u, 0u}, kv = qv;
        if (t >= 0) { const size_t o = (size_t)(b * LP + t) * 1024 + h * 128 + c8 * 8; qv = *(const u32x4*)(WSP(bf16_t, WS_QR) + o); kv = *(const u32x4*)(WSP(bf16_t, WS_KR) + o); }
        const f32x4 a0 = *(const LAS f32x4*)(A + i * HC_ASTR + c8 * 8), a1 = *(const LAS f32x4*)(A + i * HC_ASTR + c8 * 8 + 4);
        const f32x4 r0 = *(const LAS f32x4*)(A + 31 * HC_ASTR + c8 * 8), r1 = *(const LAS f32x4*)(A + 31 * HC_ASTR + c8 * 8 + 4);
        f32x4 eq0, eq1, ek0, ek1;
#pragma unroll
        for (int e = 0; e < 4; ++e) { eq0[e] = __expf(a0[e] - r0[e]); eq1[e] = __expf(a1[e] - r1[e]); ek0[e] = __expf(r0[e] - a0[e]); ek1[e] = __expf(r1[e] - a1[e]); }
        const f32x4 q0 = (f32x4){bflo(qv.x), bfhi(qv.x), bflo(qv.y), bfhi(qv.y)} * eq0, q1 = (f32x4){bflo(qv.z), bfhi(qv.z), bflo(qv.w), bfhi(qv.w)} * eq1;
        const f32x4 k0 = (f32x4){bflo(kv.x), bfhi(kv.x), bflo(kv.y), bfhi(kv.y)} * ek0, k1 = (f32x4){bflo(kv.z), bfhi(kv.z), bflo(kv.w), bfhi(kv.w)} * ek1;
        *(LAS u32x4*)(lds + HCc_QT + i * 272 + c8 * 16) = pack8(q0, q1); *(LAS u32x4*)(lds + HCc_KH + i * 272 + c8 * 16) = pack8(k0, k1); }
    chunk_transpose<0>(F, WSP(bf16_t, WS_IR), b, h, c, HCc_VT);
#pragma unroll
    for (int r = 0; r < 4; ++r) { const int q = tid + NTHR * r, dvr = q >> 4, c8 = q & 15; const u32x4 sv = *(const u32x4*)(WSP(bf16_t, WS_STB) + (size_t)uid * 16384 + (size_t)dvr * 128 + c8 * 8);
        const f32x4 r0 = *(const LAS f32x4*)(A + 31 * HC_ASTR + c8 * 8), r1 = *(const LAS f32x4*)(A + 31 * HC_ASTR + c8 * 8 + 4);
        f32x4 s0 = (f32x4){bflo(sv.x), bfhi(sv.x), bflo(sv.y), bfhi(sv.y)}, s1 = (f32x4){bflo(sv.z), bfhi(sv.z), bflo(sv.w), bfhi(sv.w)};
#pragma unroll
        for (int e = 0; e < 4; ++e) { s0[e] *= __expf(r0[e]); s1[e] *= __expf(r1[e]); }
        *(LAS u32x4*)(lds + HCc_SP + dvr * 272 + c8 * 16) = pack8(s0, s1); }
    __syncthreads();
    { const int mt = w >> 1;
      f32x4 p[2];
#pragma unroll
      for (int j = 0; j < 2; ++j) p[j] = (f32x4){0.f, 0.f, 0.f, 0.f};
#pragma unroll
      for (int ks = 0; ks < 4; ++ks) { const bf16x8 mf = ldfrag(lds + HCc_QT, mt * 16 + fr, 272, ks * 32 + fq * 8);
#pragma unroll
          for (int j = 0; j < 2; ++j) { const int nt = (w & 1) * 2 + j; const bf16x8 nf = ldfrag(lds + HCc_KH, nt * 16 + fr, 272, ks * 32 + fq * 8); MMA16(p[j], nf, mf); } }
#pragma unroll
      for (int j = 0; j < 2; ++j) { const int nt = (w & 1) * 2 + j, ti = mt * 16 + fr, s0 = nt * 16 + fq * 4; float pv[4];
#pragma unroll
          for (int e = 0; e < 4; ++e) pv[e] = (s0 + e <= ti) ? p[j][e] : 0.f;
          u32x2 pw; pw.x = pk2(pv[0], pv[1]); pw.y = pk2(pv[2], pv[3]); *(LAS u32x2*)(lds + HCc_PS + ti * 144 + s0 * 2) = pw; } }
    __syncthreads();
    { const int mt = w & 3, nb = (w >> 2) * 4; f32x4 o[4];
#pragma unroll
      for (int n = 0; n < 4; ++n) o[n] = (f32x4){0.f, 0.f, 0.f, 0.f};
#pragma unroll
      for (int ks = 0; ks < 2; ++ks) { const bf16x8 mf = ldfrag(lds + HCc_PS, mt * 16 + fr, 144, ks * 32 + fq * 8);
#pragma unroll
          for (int n = 0; n < 4; ++n) { const bf16x8 nf = ldfrag(lds + HCc_VT, (nb + n) * 16 + fr, 144, ks * 32 + fq * 8); MMA16(o[n], nf, mf); } }
#pragma unroll
      for (int ks = 0; ks < 4; ++ks) { const bf16x8 mf = ldfrag(lds + HCc_QT, mt * 16 + fr, 272, ks * 32 + fq * 8);
#pragma unroll
          for (int n = 0; n < 4; ++n) { const bf16x8 nf = ldfrag(lds + HCc_SP, (nb + n) * 16 + fr, 272, ks * 32 + fq * 8); MMA16(o[n], nf, mf); } }
      float ss = 0.f;
#pragma unroll
      for (int n = 0; n < 4; ++n) ss += (o[n][0] * o[n][0] + o[n][1] * o[n][1]) + (o[n][2] * o[n][2] + o[n][3] * o[n][3]);
      ss += __shfl_xor(ss, 16); ss += __shfl_xor(ss, 32);
      const int ti = mt * 16 + fr;
      if (fq == 0) ((LAS float*)(lds + HCc_RED))[(w >> 2) * 64 + ti] = ss;
      __syncthreads();
      const float tot = ((const LAS float*)(lds + HCc_RED))[ti] + ((const LAS float*)(lds + HCc_RED))[64 + ti];
      const float rn = rsqrtf(tot * (1.f / 128.f) + EPS);
      const int t = 64 * c - 48 + ti;
      if (t >= 0) { const size_t row = (size_t)(b * LP + t);
#pragma unroll
          for (int n = 0; n < 4; ++n) { const int col = h * 128 + (nb + n) * 16 + fq * 4; const f32x4 nw = *(const f32x4*)(in_hnorm_w + l * 1024 + col); const u32x2 g = *(const u32x2*)(WSP(bf16_t, WS_GR) + row * 1024 + col);
              u32x2 yw; yw.x = pk2(o[n][0] * rn * nw[0] * bflo(g.x), o[n][1] * rn * nw[1] * bfhi(g.x)); yw.y = pk2(o[n][2] * rn * nw[2] * bflo(g.y), o[n][3] * rn * nw[3] * bfhi(g.y));
              *(u32x2*)(WSP(bf16_t, WS_Y) + row * DM + 1024 + col) = yw; } } }
    __syncthreads();
}

typedef short v4i16_t __attribute__((ext_vector_type(4)));
__device__ __forceinline__ bf16x8 tr_frag(const LAS unsigned char* base, int stride_b, int k0, int d0, int lane) {
    const int g = lane >> 4, i = lane & 15;
    const LAS unsigned char* p = base + (k0 + 8 * g + (i >> 2)) * stride_b + (d0 + 4 * (i & 3)) * 2;
    const v4i16_t lo = __builtin_amdgcn_ds_read_tr16_b64_v4i16((LAS v4i16_t*)p);
    const v4i16_t hi = __builtin_amdgcn_ds_read_tr16_b64_v4i16((LAS v4i16_t*)(p + 4 * stride_b));
    return (bf16x8){lo[0], lo[1], lo[2], lo[3], hi[0], hi[1], hi[2], hi[3]};
}
__device__ __forceinline__ f32x4 unlo(const u32x4 v) { return (f32x4){bflo(v.x), bfhi(v.x), bflo(v.y), bfhi(v.y)}; }
__device__ __forceinline__ f32x4 unhi(const u32x4 v) { return (f32x4){bflo(v.z), bfhi(v.z), bflo(v.w), bfhi(v.w)}; }
constexpr u32x4 U4Z = {0u, 0u, 0u, 0u};
__device__ __forceinline__ u32x4 mask4(const u32x4 v, int t) { const unsigned m = ~(unsigned)(t >> 31); return (u32x4){v.x & m, v.y & m, v.z & m, v.w & m}; }
__device__ __forceinline__ f32x4 maskf4(const f32x4 v, int t) { return __builtin_bit_cast(f32x4, mask4(__builtin_bit_cast(u32x4, v), t)); }
__device__ __forceinline__ u32x2 mask2(const u32x2 v, int t) { const unsigned m = ~(unsigned)(t >> 31); return (u32x2){v.x & m, v.y & m}; }

__device__ __forceinline__ void cumsum_regs(Frame& F, int tid, const f32x4 (&lf)[4]) {
    LAS float* A = (LAS float*)(F.lds + HC_A); LAS float* TOT = (LAS float*)(F.lds + HC_TOT);
#pragma unroll
    for (int r = 0; r < 4; ++r) { const int q = tid + NTHR * r; *(LAS f32x4*)(A + (q >> 5) * HC_ASTR + (q & 31) * 4) = lf[r]; }
    __syncthreads();
    const int d = tid & 127, sg = tid >> 7; float v[16]; float run = 0.f;
#pragma unroll
    for (int i = 0; i < 16; ++i) { run += A[(sg * 16 + i) * HC_ASTR + d]; v[i] = run; }
    TOT[sg * 128 + d] = run;
    __syncthreads();
    float off = 0.f;
#pragma unroll
    for (int s = 0; s < 3; ++s) if (s < sg) off += TOT[s * 128 + d];
#pragma unroll
    for (int i = 0; i < 16; ++i) A[(sg * 16 + i) * HC_ASTR + d] = v[i] + off;
    __syncthreads();
}

constexpr int PA_KS = HC_END, PA_VS = PA_KS + 17408;
struct PARegs { f32x4 lf[4]; u32x4 kr[2], ir[2]; };
__device__ __forceinline__ void passA_load(Frame& F, int uid, PARegs& R) {
    GAS unsigned char* const ws = WSB(); const int tid = opq(F.tid);
    const int bh = uid / NCH, c = uid % NCH, b = bh >> 3, h = bh & 7;
#pragma unroll
    for (int r = 0; r < 4; ++r) { const int q = tid + NTHR * r, i = q >> 5, c4 = q & 31, t = 64 * c - 48 + i, tt = t < 0 ? 0 : t;
        const f32x4 v = *(const f32x4*)(WSP(const float, WS_LOGF) + (size_t)(b * LP + tt) * 1024 + h * 128 + c4 * 4); R.lf[r] = maskf4(v, t); }
#pragma unroll
    for (int r = 0; r < 2; ++r) { const int q = tid + NTHR * r, i = q >> 4, c8 = q & 15, t = 64 * c - 48 + i, tt = t < 0 ? 0 : t; const size_t o = (size_t)(b * LP + tt) * 1024 + h * 128 + c8 * 8;
        const u32x4 kv = *(const u32x4*)(WSP(const bf16_t, WS_KR) + o), iv = *(const u32x4*)(WSP(const bf16_t, WS_IR) + o); R.kr[r] = mask4(kv, t); R.ir[r] = mask4(iv, t); }
}
__device__ __forceinline__ void passA_compute(Frame& F, int uid, const PARegs& R) {
    GAS unsigned char* const ws = WSB(); const int tid = opq(F.tid), lane = tid & 63, w = F.wave, fr = lane & 15, fq = lane >> 4; LAS unsigned char* lds = F.lds;
    cumsum_regs(F, tid, R.lf);
    const LAS float* A = (const LAS float*)(lds + HC_A);
#pragma unroll
    for (int r = 0; r < 2; ++r) { const int q = tid + NTHR * r, i = q >> 4, c8 = q & 15;
        const f32x4 a0 = *(const LAS f32x4*)(A + i * HC_ASTR + c8 * 8), a1 = *(const LAS f32x4*)(A + i * HC_ASTR + c8 * 8 + 4);
        const f32x4 l0 = *(const LAS f32x4*)(A + 63 * HC_ASTR + c8 * 8), l1 = *(const LAS f32x4*)(A + 63 * HC_ASTR + c8 * 8 + 4);
        f32x4 k0 = unlo(R.kr[r]), k1 = unhi(R.kr[r]);
#pragma unroll
        for (int e = 0; e < 4; ++e) { k0[e] *= __expf(l0[e] - a0[e]); k1[e] *= __expf(l1[e] - a1[e]); }
        *(LAS u32x4*)(lds + PA_KS + i * 272 + c8 * 16) = pack8(k0, k1); *(LAS u32x4*)(lds + PA_VS + i * 272 + c8 * 16) = R.ir[r]; }
    if (tid < 128) WSP(float, WS_GD)[(size_t)uid * 128 + tid] = __expf(A[63 * HC_ASTR + tid]);
    __syncthreads();
    f32x4 acc[8];
#pragma unroll
    for (int n = 0; n < 8; ++n) acc[n] = (f32x4){0.f, 0.f, 0.f, 0.f};
#pragma unroll
    for (int ks = 0; ks < 2; ++ks) { const bf16x8 mf = tr_frag(lds + PA_VS, 272, ks * 32, w * 16, lane);
#pragma unroll
        for (int n = 0; n < 8; ++n) { const bf16x8 nf = tr_frag(lds + PA_KS, 272, ks * 32, n * 16, lane); MMA16(acc[n], nf, mf); } }
    float* ut = WSP(float, WS_UT) + (size_t)uid * 16384 + (size_t)(w * 16 + fr) * 128;
#pragma unroll
    for (int n = 0; n < 8; ++n) *(f32x4*)(ut + n * 16 + fq * 4) = acc[n];
}

constexpr int PC_QT = HC_END, PC_KH = PC_QT + 17408, PC_VS = PC_KH + 17408, PC_SP = PC_VS + 17408, PC_PS = PC_SP + 34816, PC_RED = PC_PS + 9216, PC_END = PC_RED + 512;
static_assert(PC_END <= LDS_BYTES - 512, "pass C LDS");
struct PCRegs { f32x4 lf[4]; u32x4 qr[2], kr[2], ir[2], st[4]; u32x2 gr[4]; };
__device__ __forceinline__ void passC_load(Frame& F, int uid, PCRegs& R) {
    GAS unsigned char* const ws = WSB(); const int tid = opq(F.tid), lane = tid & 63, w = F.wave, fr = lane & 15, fq = lane >> 4;
    const int bh = uid / NCH, c = uid % NCH, b = bh >> 3, h = bh & 7;
#pragma unroll
    for (int r = 0; r < 4; ++r) { const int q = tid + NTHR * r, i = q >> 5, c4 = q & 31, t = 64 * c - 48 + i, tt = t < 0 ? 0 : t;
        const f32x4 v = *(const f32x4*)(WSP(const float, WS_LOGF) + (size_t)(b * LP + tt) * 1024 + h * 128 + c4 * 4); R.lf[r] = maskf4(v, t); }
#pragma unroll
    for (int r = 0; r < 2; ++r) { const int q = tid + NTHR * r, i = q >> 4, c8 = q & 15, t = 64 * c - 48 + i, tt = t < 0 ? 0 : t; const size_t o = (size_t)(b * LP + tt) * 1024 + h * 128 + c8 * 8;
        const u32x4 qv = *(const u32x4*)(WSP(const bf16_t, WS_QR) + o), kv = *(const u32x4*)(WSP(const bf16_t, WS_KR) + o), iv = *(const u32x4*)(WSP(const bf16_t, WS_IR) + o);
        R.qr[r] = t >= 0 ? qv : U4Z; R.kr[r] = mask4(kv, t); R.ir[r] = mask4(iv, t); }
#pragma unroll
    for (int r = 0; r < 4; ++r) { const int q = tid + NTHR * r; R.st[r] = *(const u32x4*)(WSP(const bf16_t, WS_STB) + (size_t)uid * 16384 + (size_t)(q >> 4) * 128 + (q & 15) * 8); }
    { const int mt = w & 3, nb = (w >> 2) * 4, ti = mt * 16 + fr, t = 64 * c - 48 + ti, tt = t < 0 ? 0 : t;
#pragma unroll
      for (int n = 0; n < 4; ++n) R.gr[n] = *(const u32x2*)(WSP(const bf16_t, WS_GR) + (size_t)(b * LP + tt) * 1024 + h * 128 + (nb + n) * 16 + fq * 4); }
}
__device__ __forceinline__ void passC_compute(Frame& F, int l, int uid, const PCRegs& R) {
    GAS unsigned char* const ws = WSB(); const float* const in_hnorm_w = INP(I_HNW);
    const int tid = opq(F.tid), lane = tid & 63, w = F.wave, fr = lane & 15, fq = lane >> 4; LAS unsigned char* lds = F.lds;
    const int bh = uid / NCH, c = uid % NCH, b = bh >> 3, h = bh & 7;
    cumsum_regs(F, tid, R.lf);
    const LAS float* A = (const LAS float*)(lds + HC_A);
#pragma unroll
    for (int r = 0; r < 2; ++r) { const int q = tid + NTHR * r, i = q >> 4, c8 = q & 15;
        const f32x4 a0 = *(const LAS f32x4*)(A + i * HC_ASTR + c8 * 8), a1 = *(const LAS f32x4*)(A + i * HC_ASTR + c8 * 8 + 4);
        const f32x4 r0 = *(const LAS f32x4*)(A + 31 * HC_ASTR + c8 * 8), r1 = *(const LAS f32x4*)(A + 31 * HC_ASTR + c8 * 8 + 4);
        f32x4 q0 = unlo(R.qr[r]), q1 = unhi(R.qr[r]), k0 = unlo(R.kr[r]), k1 = unhi(R.kr[r]);
#pragma unroll
        for (int e = 0; e < 4; ++e) { const float e0 = __expf(a0[e] - r0[e]), e1 = __expf(a1[e] - r1[e]); q0[e] *= e0; q1[e] *= e1; k0[e] *= __frcp_rn(e0); k1[e] *= __frcp_rn(e1); }
        *(LAS u32x4*)(lds + PC_QT + i * 272 + c8 * 16) = pack8(q0, q1); *(LAS u32x4*)(lds + PC_KH + i * 272 + c8 * 16) = pack8(k0, k1);
        *(LAS u32x4*)(lds + PC_VS + i * 272 + c8 * 16) = R.ir[r]; }
    { const int c8 = tid & 15;
      const f32x4 r0 = *(const LAS f32x4*)(A + 31 * HC_ASTR + c8 * 8), r1 = *(const LAS f32x4*)(A + 31 * HC_ASTR + c8 * 8 + 4); f32x4 g0, g1;
#pragma unroll
      for (int e = 0; e < 4; ++e) { g0[e] = __expf(r0[e]); g1[e] = __expf(r1[e]); }
#pragma unroll
      for (int r = 0; r < 4; ++r) { const int q = tid + NTHR * r; *(LAS u32x4*)(lds + PC_SP + (q >> 4) * 272 + c8 * 16) = pack8(unlo(R.st[r]) * g0, unhi(R.st[r]) * g1); } }
    __syncthreads();
    { const int mt = w >> 1; f32x4 p[2];
#pragma unroll
      for (int j = 0; j < 2; ++j) p[j] = (f32x4){0.f, 0.f, 0.f, 0.f};
#pragma unroll
      for (int ks = 0; ks < 4; ++ks) { const bf16x8 mf = ldfrag(lds + PC_QT, mt * 16 + fr, 272, ks * 32 + fq * 8);
#pragma unroll
          for (int j = 0; j < 2; ++j) { const int nt = (w & 1) * 2 + j; const bf16x8 nf = ldfrag(lds + PC_KH, nt * 16 + fr, 272, ks * 32 + fq * 8); MMA16(p[j], nf, mf); } }
#pragma unroll
      for (int j = 0; j < 2; ++j) { const int nt = (w & 1) * 2 + j, ti = mt * 16 + fr, s0 = nt * 16 + fq * 4; float pv[4];
#pragma unroll
          for (int e = 0; e < 4; ++e) pv[e] = (s0 + e <= ti) ? p[j][e] : 0.f;
          u32x2 pw; pw.x = pk2(pv[0], pv[1]); pw.y = pk2(pv[2], pv[3]); *(LAS u32x2*)(lds + PC_PS + ti * 144 + s0 * 2) = pw; } }
    __syncthreads();
    { const int mt = w & 3, nb = (w >> 2) * 4, ti = mt * 16 + fr, t = 64 * c - 48 + ti; f32x4 o[4], nw[4];
#pragma unroll
      for (int n = 0; n < 4; ++n) { o[n] = (f32x4){0.f, 0.f, 0.f, 0.f}; nw[n] = *(const f32x4*)(in_hnorm_w + l * 1024 + h * 128 + (nb + n) * 16 + fq * 4); }
#pragma unroll
      for (int ks = 0; ks < 2; ++ks) { const bf16x8 mf = ldfrag(lds + PC_PS, mt * 16 + fr, 144, ks * 32 + fq * 8);
#pragma unroll
          for (int n = 0; n < 4; ++n) { const bf16x8 nf = tr_frag(lds + PC_VS, 272, ks * 32, (nb + n) * 16, lane); MMA16(o[n], nf, mf); } }
#pragma unroll
      for (int ks = 0; ks < 4; ++ks) { const bf16x8 mf = ldfrag(lds + PC_QT, mt * 16 + fr, 272, ks * 32 + fq * 8);
#pragma unroll
          for (int n = 0; n < 4; ++n) { const bf16x8 nf = ldfrag(lds + PC_SP, (nb + n) * 16 + fr, 272, ks * 32 + fq * 8); MMA16(o[n], nf, mf); } }
      float ss = 0.f;
#pragma unroll
      for (int n = 0; n < 4; ++n) ss += (o[n][0] * o[n][0] + o[n][1] * o[n][1]) + (o[n][2] * o[n][2] + o[n][3] * o[n][3]);
      ss += __shfl_xor(ss, 16); ss += __shfl_xor(ss, 32);
      if (fq == 0) ((LAS float*)(lds + PC_RED))[(w >> 2) * 64 + ti] = ss;
      __syncthreads();
      const float tot = ((const LAS float*)(lds + PC_RED))[ti] + ((const LAS float*)(lds + PC_RED))[64 + ti];
      const float rn = rsqrtf(tot * (1.f / 128.f) + EPS);
      if (t >= 0) { const size_t row = (size_t)(b * LP + t);
#pragma unroll
          for (int n = 0; n < 4; ++n) { const int col = h * 128 + (nb + n) * 16 + fq * 4; const u32x2 g = R.gr[n];
              u32x2 yw; yw.x = pk2(o[n][0] * rn * nw[n][0] * bflo(g.x), o[n][1] * rn * nw[n][1] * bfhi(g.x)); yw.y = pk2(o[n][2] * rn * nw[n][2] * bflo(g.y), o[n][3] * rn * nw[n][3] * bfhi(g.y));
              *(u32x2*)(WSP(bf16_t, WS_Y) + row * DM + 1024 + col) = yw; } } }
}

constexpr int AB_KS = 0, AB_VS = 36864, AB_QS = 73728, AB_PS = 92160, AB_BT = 135168;
static_assert(AB_BT + 2048 <= LDS_BYTES - 512, "attention LDS");
__device__ __forceinline__ void attn_big_unit(Frame& F, int l, int unit) {
    GAS unsigned char* const ws = WSB(); const float* const in_sinks = INP(I_SINK);
    const int tid = opq(F.tid), lane = tid & 63, w = F.wave, fr = lane & 15, fq = lane >> 4; LAS unsigned char* lds = F.lds;
    const int bk = unit >> 4, seg = unit & 15, b = bk >> 2, kvh = bk & 3, p0 = NMETA + 128 * seg, kbase = p0 - WIN, rowbase = b * LP;
    const int r = w * 16 + fr, hl = r >> 5, qi = r & 31, hc = (kvh * 4 + hl) * 64;
    u32x4 qv[2]; u32x2 ga[4];
#pragma unroll
    for (int rr = 0; rr < 2; ++rr) { const int q = tid + NTHR * rr, row = q >> 3, c8 = q & 7; qv[rr] = *(const u32x4*)(WSP(const bf16_t, WS_Q) + (size_t)(rowbase + p0 + (row & 31)) * 1024 + (kvh * 4 + (row >> 5)) * 64 + c8 * 8); }
#pragma unroll
    for (int n = 0; n < 4; ++n) ga[n] = *(const u32x2*)(WSP(const bf16_t, WS_GA) + (size_t)(rowbase + p0 + qi) * 1024 + hc + n * 16 + fq * 4);
#pragma unroll
    for (int rr = 0; rr < 4; ++rr) { const int q = tid + NTHR * rr, j = q >> 3, c8 = q & 7, kp = kbase + j, kk = kp < 0 ? 0 : kp; const size_t o = (size_t)(rowbase + kk) * 256 + kvh * 64 + c8 * 8;
        const u32x4 kv = *(const u32x4*)(WSP(const bf16_t, WS_KB) + o), vv = *(const u32x4*)(WSP(const bf16_t, WS_VB) + o);
        *(LAS u32x4*)(lds + AB_KS + j * 144 + c8 * 16) = mask4(kv, kp); *(LAS u32x4*)(lds + AB_VS + j * 144 + c8 * 16) = mask4(vv, kp); }
    ((LAS float*)(lds + AB_BT))[tid] = WSP(const float, WS_BIAS)[(kvh * 4 + (tid >> 7)) * 128 + (tid & 127)];
    const float sink = in_sinks[l * 16 + kvh * 4 + hl];
    const LAS float* bt = (const LAS float*)(lds + AB_BT) + hl * 128;
#pragma unroll 1
    for (int blk = 0; blk < 4; ++blk) {
#pragma unroll
        for (int rr = 0; rr < 2; ++rr) { const int q = tid + NTHR * rr; *(LAS u32x4*)(lds + AB_QS + (q >> 3) * 144 + (q & 7) * 16) = qv[rr]; }
        u32x2 gac[4];
#pragma unroll
        for (int n = 0; n < 4; ++n) gac[n] = ga[n];
        __syncthreads();
        if (blk < 3) {
#pragma unroll
            for (int rr = 0; rr < 2; ++rr) { const int q = tid + NTHR * rr, row = q >> 3, c8 = q & 7; qv[rr] = *(const u32x4*)(WSP(const bf16_t, WS_Q) + (size_t)(rowbase + p0 + 32 * (blk + 1) + (row & 31)) * 1024 + (kvh * 4 + (row >> 5)) * 64 + c8 * 8); }
#pragma unroll
            for (int n = 0; n < 4; ++n) ga[n] = *(const u32x2*)(WSP(const bf16_t, WS_GA) + (size_t)(rowbase + p0 + 32 * (blk + 1) + qi) * 1024 + hc + n * 16 + fq * 4);
        }
        f32x4 acc[10];
#pragma unroll
        for (int n = 0; n < 10; ++n) acc[n] = (f32x4){0.f, 0.f, 0.f, 0.f};
#pragma unroll
        for (int ks = 0; ks < 2; ++ks) { const bf16x8 mf = ldfrag(lds + AB_QS, r, 144, ks * 32 + fq * 8);
#pragma unroll
            for (int n = 0; n < 10; ++n) { const bf16x8 nf = ldfrag(lds + AB_KS, 32 * blk + n * 16 + fr, 144, ks * 32 + fq * 8); MMA16(acc[n], nf, mf); } }
        const int p = p0 + 32 * blk + qi, kb2 = kbase + 32 * blk;
        float mx = -INFINITY;
#pragma unroll
        for (int n = 0; n < 10; ++n)
#pragma unroll
            for (int e = 0; e < 4; ++e) { const int kp = kb2 + n * 16 + fq * 4 + e, dist = p - kp; const bool ok = dist >= 0 && dist < WIN && kp >= 0;
                const float s = ok ? acc[n][e] + bt[dist & 127] : -INFINITY; acc[n][e] = s; mx = fmaxf(mx, s); }
        mx = fmaxf(mx, __shfl_xor(mx, 16)); mx = fmaxf(mx, __shfl_xor(mx, 32));
        const float mm = fmaxf(mx, sink);
        float sum = 0.f;
#pragma unroll
        for (int n = 0; n < 10; ++n)
#pragma unroll
            for (int e = 0; e < 4; ++e) { const float ev = __expf(acc[n][e] - mm); acc[n][e] = ev; sum += ev; }
        sum += __shfl_xor(sum, 16); sum += __shfl_xor(sum, 32);
        const float inv = 1.f / (sum + __expf(sink - mm));
#pragma unroll
        for (int n = 0; n < 10; ++n) { u32x2 pw; pw.x = pk2(acc[n][0] * inv, acc[n][1] * inv); pw.y = pk2(acc[n][2] * inv, acc[n][3] * inv);
            *(LAS u32x2*)(lds + AB_PS + r * 336 + (n * 16 + fq * 4) * 2) = pw; }
        LDS_WAIT(); asm volatile("" ::: "memory");
        f32x4 o[4];
#pragma unroll
        for (int n = 0; n < 4; ++n) o[n] = (f32x4){0.f, 0.f, 0.f, 0.f};
#pragma unroll
        for (int ks = 0; ks < 5; ++ks) { const bf16x8 mf = ldfrag(lds + AB_PS, r, 336, ks * 32 + fq * 8);
#pragma unroll
            for (int n = 0; n < 4; ++n) { const bf16x8 nf = tr_frag(lds + AB_VS + 32 * blk * 144, 144, ks * 32, n * 16, lane); MMA16(o[n], nf, mf); } }
        { const size_t grow = (size_t)(rowbase + p);
#pragma unroll
          for (int n = 0; n < 4; ++n) { const int d = n * 16 + fq * 4; const u32x2 g = gac[n];
              u32x2 yw; yw.x = pk2(o[n][0] * bflo(g.x), o[n][1] * bfhi(g.x)); yw.y = pk2(o[n][2] * bflo(g.y), o[n][3] * bfhi(g.y));
              *(u32x2*)(WSP(bf16_t, WS_Y) + grow * DM + hc + d) = yw; } }
        __syncthreads();
    }
}

struct HSRegs { float S[32]; float vv[8]; float fk[2], kk[2], qq[2]; };
__device__ __forceinline__ void hs_load(Frame& F, int l, int unit, HSRegs& R) {
    GAS unsigned char* const ws = WSB(); const float* const in_state_h = INP(I_ST); const int tid = opq(F.tid);
    const int b = unit >> 3, h = unit & 7, dv = tid & 127, qd = tid >> 7, rowbase = MPR + b * DSEQ;
    const size_t sbase = ((((size_t)l * DBATCH + b) * 8 + h) * 128) * 128;
#pragma unroll
    for (int i = 0; i < 32; ++i) R.S[i] = in_state_h[sbase + (size_t)(qd * 32 + i) * 128 + dv];
#pragma unroll
    for (int r = 0; r < 2; ++r) { const int e = tid + NTHR * r, t = e >> 7, d = e & 127; const size_t o = (size_t)(rowbase + t) * 1024 + h * 128 + d;
        R.fk[r] = WSP(const float, WS_LOGF)[o]; R.kk[r] = bf2f(WSP(const bf16_t, WS_KR)[o]); R.qq[r] = bf2f(WSP(const bf16_t, WS_QR)[o]); }
#pragma unroll
    for (int t = 0; t < 8; ++t) R.vv[t] = bf2f(WSP(const bf16_t, WS_IR)[(size_t)(rowbase + t) * 1024 + h * 128 + dv]);
}
__device__ __forceinline__ void hs_compute(Frame& F, int l, int unit, HSRegs& R) {
    GAS unsigned char* const ws = WSB(); float* const out = OUTP(); const float* const in_hnorm_w = INP(I_HNW);
    const int tid = opq(F.tid), lane = tid & 63, w = F.wave; LAS unsigned char* lds = F.lds;
    const int b = unit >> 3, h = unit & 7, dv = tid & 127, qd = tid >> 7, rowbase = MPR + b * DSEQ;
    const size_t sbase = ((((size_t)l * DBATCH + b) * 8 + h) * 128) * 128;
#pragma unroll
    for (int r = 0; r < 2; ++r) { const int e = tid + NTHR * r; ((LAS float*)(lds + HS_F))[e] = __expf(R.fk[r]); ((LAS float*)(lds + HS_K))[e] = R.kk[r]; ((LAS float*)(lds + HS_Q))[e] = R.qq[r]; }
    __syncthreads();
#pragma unroll
    for (int t = 0; t < 8; ++t) { const LAS float* fp = (const LAS float*)(lds + HS_F) + t * 128 + qd * 32; const LAS float* kp = (const LAS float*)(lds + HS_K) + t * 128 + qd * 32; const LAS float* qp = (const LAS float*)(lds + HS_Q) + t * 128 + qd * 32;
        float part = 0.f;
#pragma unroll
        for (int i = 0; i < 32; ++i) { R.S[i] = fp[i] * R.S[i] + kp[i] * R.vv[t]; part += R.S[i] * qp[i]; }
        ((LAS float*)(lds + HS_OP))[(t * 4 + qd) * 128 + dv] = part; }
#pragma unroll
    for (int i = 0; i < 32; ++i) out[O_SSH + sbase + (size_t)(qd * 32 + i) * 128 + dv] = R.S[i];
    __syncthreads();
    { const int t = w; const LAS float* op = (const LAS float*)(lds + HS_OP) + t * 512;
      const float o0 = op[lane] + op[128 + lane] + op[256 + lane] + op[384 + lane], o1 = op[64 + lane] + op[192 + lane] + op[320 + lane] + op[448 + lane];
      const float ss = wave_sum(o0 * o0 + o1 * o1), rn = rsqrtf(ss * (1.f / 128.f) + EPS);
      const size_t row = (size_t)(rowbase + t); const int c0 = h * 128 + lane, c1 = c0 + 64;
      const float y0 = o0 * rn * in_hnorm_w[l * 1024 + c0] * bf2f(WSP(const bf16_t, WS_GR)[row * 1024 + c0]), y1 = o1 * rn * in_hnorm_w[l * 1024 + c1] * bf2f(WSP(const bf16_t, WS_GR)[row * 1024 + c1]);
      WSP(bf16_t, WS_Y)[row * DM + 1024 + c0] = (bf16_t)f2bf(y0); WSP(bf16_t, WS_Y)[row * DM + 1024 + c1] = (bf16_t)f2bf(y1); }
    __syncthreads();
}

__device__ __forceinline__ void hgrn_scan_unit2(Frame& F, int l, int unit) {
    GAS unsigned char* const ws = WSB(); float* const out = OUTP();
    const int bh = unit >> 3, sl = unit & 7, tid = opq(F.tid), dvr = sl * 16 + (tid >> 5), dk = (tid & 31) * 4;
    const float* ut = WSP(const float, WS_UT) + (size_t)bh * NCH * 16384 + (size_t)dvr * 128 + dk; const float* gd = WSP(const float, WS_GD) + (size_t)bh * NCH * 128 + dk;
    bf16_t* sb = WSP(bf16_t, WS_STB) + (size_t)bh * NCH * 16384 + (size_t)dvr * 128 + dk;
    f32x4 S = (f32x4){0.f, 0.f, 0.f, 0.f};
    f32x4 ub[2][8], gb[2][8];
#pragma unroll
    for (int j = 0; j < 8; ++j) { ub[0][j] = *(const f32x4*)(ut + (size_t)j * 16384); gb[0][j] = *(const f32x4*)(gd + (size_t)j * 128); }
#pragma unroll
    for (int bt = 0; bt < 5; ++bt) {
        if (bt < 4) {
#pragma unroll
            for (int j = 0; j < 8; ++j) { const int cc = 8 * (bt + 1) + j; if (cc < NCH) { ub[(bt + 1) & 1][j] = *(const f32x4*)(ut + (size_t)cc * 16384); gb[(bt + 1) & 1][j] = *(const f32x4*)(gd + (size_t)cc * 128); } }
        }
#pragma unroll
        for (int j = 0; j < 8; ++j) { const int cc = 8 * bt + j; if (cc < NCH) { u32x2 sw; sw.x = pk2(S[0], S[1]); sw.y = pk2(S[2], S[3]); *(u32x2*)(sb + (size_t)cc * 16384) = sw; S = gb[bt & 1][j] * S + ub[bt & 1][j]; } }
    }
    float* o = out + O_PSH + (((size_t)l * NBATCH * 8 + bh) * 128) * 128;
#pragma unroll
    for (int e = 0; e < 4; ++e) o[(size_t)(dk + e) * 128 + dvr] = S[e];
}

__device__ __forceinline__ void phase_final(Frame& F) {
    GAS unsigned char* const ws = WSB(); float* const out = OUTP(); const float* const in_final_w = INP(I_FW);
    const int gw = F.bid * NWAVES + F.wave, NGW = F.G * NWAVES; const float* ssq = WSP(float, WS_SSQ) + 4 * MPAD;
    for (int i = gw; i < NBATCH * SEQ + MSA; i += NGW) {
        int row; float* dst;
        if (i < NBATCH * SEQ) { const int b = i / SEQ, s = i % SEQ; row = b * LP + NMETA + s; dst = out + O_YP + (size_t)i * DM; }
        else { row = MPR + (i - NBATCH * SEQ); dst = out + O_YS + (size_t)(i - NBATCH * SEQ) * DM; }
        const float rs = rsqrtf(ssq[row] * (1.f / 2048.f) + EPS);
#pragma unroll
        for (int j = 0; j < 4; ++j) { const int c = (F.lane + 64 * j) * 8; const u32x4 hv = *(const u32x4*)(WSP(bf16_t, WS_HB) + (size_t)row * DM + c);
            const f32x4 w0 = *(const f32x4*)(in_final_w + c), w1 = *(const f32x4*)(in_final_w + c + 4);
            *(f32x4*)(dst + c) = (f32x4){bflo(hv.x), bfhi(hv.x), bflo(hv.y), bfhi(hv.y)} * rs * w0; *(f32x4*)(dst + c + 4) = (f32x4){bflo(hv.z), bfhi(hv.z), bflo(hv.w), bfhi(hv.w)} * rs * w1; }
    }
}

constexpr int NPHASE = 22;
constexpr int REP_PRO = 1, REP_GIN = 1, REP_MIXA = 1, REP_SCAN = 1, REP_PC = 1;
constexpr int NMIXA = NUNIT + 4 * 4 * 65 + DBATCH * 4 + DBATCH * 8;

#ifndef EN_PRO
#define EN_PRO 1
#endif
#ifndef EN_GIN
#define EN_GIN 1
#endif
#ifndef EN_GOUT
#define EN_GOUT 1
#endif
#ifndef EN_PA
#define EN_PA 1
#endif
#ifndef EN_ATT
#define EN_ATT 1
#endif
#ifndef EN_HS
#define EN_HS 1
#endif
#ifndef EN_SCAN
#define EN_SCAN 1
#endif
#ifndef EN_PC
#define EN_PC 1
#endif
#ifndef EN_ATT2
#define EN_ATT2 1
#endif
#ifndef EN_FIN
#define EN_FIN 1
#endif
__global__ void __launch_bounds__(NTHR, 2) hymba_fwd(Args args) {
    extern __shared__ __attribute__((aligned(16))) unsigned char lds_raw[];
    Frame F;
    F.lds = (LAS unsigned char*)lds_raw;
    F.tid = threadIdx.x; F.lane = F.tid & 63; F.wave = __builtin_amdgcn_readfirstlane(F.tid >> 6); F.G = gridDim.x; F.bid = blockIdx.x;
    volatile LAS unsigned* MISC = (volatile LAS unsigned*)(F.lds + MISC_OFF);
    if (F.tid < 32) MISC[F.tid] = 0u;
    if (F.tid == 0) { LAS unsigned long long* pt = (LAS unsigned long long*)(F.lds + PT_OFF);
#pragma unroll
        for (int i = 0; i < 14; ++i) pt[i] = (unsigned long long)args.in[i];
        pt[14] = (unsigned long long)args.out; pt[15] = (unsigned long long)args.ws; }
    __syncthreads();
    const int lo = args.ph_lo, hi = args.ph_hi;
    XcdBarrier bar; bar.bar = nullptr; bar.x = 0; bar.st = nullptr;
    if ((hi - lo) > 1) bar = xcd_barrier_post((unsigned*)WSB() + CW_BAR, MISC + 8);
#define IN(k) (lo <= (k) && (k) < hi)
#define SEAM(k) do { if (IN(k) && IN((k) + 1)) xcd_barrier(bar); } while (0)

    if (EN_PRO && IN(0)) { for (int rep = 0; rep < REP_PRO; ++rep) phase_prologue(F); }
    SEAM(0);
#pragma unroll 1
    for (int l = 0; l < DEPTH; ++l) {
        const int pb = 1 + 5 * l;
        if (EN_GIN && IN(pb)) {
            GAS unsigned char* const ws = WSB();
            pg8::Gemm g{WSP(bf16_t, WS_HB), WSP(bf16_t, WS_WIN) + (size_t)l * DIN * DM, MPAD, DIN, DM}; pg8::StaticOrder S; S.init(MPAD, DIN, F.G, F.bid);
            EpiIn E; E.ws = ws; E.out = OUTP(); E.l = l;
            for (int rep = 0; rep < REP_GIN; ++rep) pg8::gemm_phase<EpiIn, pg8::StaticOrder>(F.lds, g, S, E);
        }
        SEAM(pb);
        if (IN(pb + 1)) for (int rep = 0; rep < REP_MIXA; ++rep) {
            HSRegs hs; const bool has_hs = F.bid < DBATCH * 8;
            if (EN_HS) hs_load(F, l, has_hs ? F.bid : DBATCH * 8 - 1, hs);
            if (EN_PA) { PARegs cur; int i = F.bid;
              passA_load(F, i < NUNIT ? i : NUNIT - 1, cur);
#pragma unroll 1
              for (; i < NUNIT; i += F.G) { PARegs nxt; passA_load(F, i + F.G < NUNIT ? i + F.G : i, nxt); passA_compute(F, i, cur); cur = nxt; }
              __syncthreads(); }
            if (EN_ATT) {
#pragma unroll 1
            for (int i = F.bid; i < 256; i += F.G) attn_big_unit(F, l, i); }
            {
                const int sidx = F.bid - (NUNIT % F.G);
                if (EN_ATT2 && sidx >= 0) {
#pragma unroll 1
                    for (int i = sidx; i < 16 + DBATCH * 4; i += F.G) { if (i < 16) attn_unit<false>(F, l, i * 65, NMETA); else attn_unit<true>(F, l, i - 16); } } }
            if (EN_HS && has_hs) hs_compute(F, l, F.bid, hs);
        }
        SEAM(pb + 1);
        if (EN_SCAN && IN(pb + 2)) for (int rep = 0; rep < REP_SCAN; ++rep) {
#pragma unroll 1
            for (int i = F.bid; i < 256; i += F.G) hgrn_scan_unit2(F, l, i);
        }
        SEAM(pb + 2);
        if (EN_PC && IN(pb + 3)) for (int rep = 0; rep < REP_PC; ++rep) {
            PCRegs cur; int i = F.bid;
            passC_load(F, i < NUNIT ? i : NUNIT - 1, cur);
#pragma unroll 1
            for (; i < NUNIT; i += F.G) { PCRegs nxt; passC_load(F, i + F.G < NUNIT ? i + F.G : i, nxt); passC_compute(F, l, i, cur); cur = nxt; }
            __syncthreads();
        }
        SEAM(pb + 3);
        if (EN_GOUT && IN(pb + 4)) {
            GAS unsigned char* const ws = WSB();
            pg8::Gemm g{WSP(bf16_t, WS_Y), WSP(bf16_t, WS_WOUT) + (size_t)l * DM * DM, MPAD, DM, DM}; pg8::StaticOrder S; S.init(MPAD, DM, F.G, F.bid);
            EpiOut E; E.ws = ws; E.l = l;
            pg8::gemm_phase<EpiOut, pg8::StaticOrder>(F.lds, g, S, E);
            if (l + 1 < DEPTH) { const int rem = ((MPAD / 256) * (DM / 256)) % F.G;
                if (F.bid >= rem) conv_layer(F, l + 1, F.bid - rem, F.G - rem); }
        }
        SEAM(pb + 4);
    }
    if (EN_FIN && IN(21)) phase_final(F);
#undef IN
#undef SEAM
}

extern "C" void kernel_launch(void* const* d_in, const int* in_sizes, int n_in, void* d_out, int out_size, void* d_ws, size_t ws_size, hipStream_t stream) {
    static int grid = 0;
    if (grid == 0) {
        if (n_in != 14 || ws_size < WS_END) { fprintf(stderr, "kernel_launch: unexpected problem (n_in %d, ws %zu < %zu)\n", n_in, ws_size, (size_t)WS_END); grid = -1; return; }
        int dev = 0, cus = 0, per_cu = 0;
        if (hipGetDevice(&dev) != hipSuccess || hipDeviceGetAttribute(&cus, hipDeviceAttributeMultiprocessorCount, dev) != hipSuccess) { grid = -1; return; }
        if (hipFuncSetAttribute((const void*)hymba_fwd, hipFuncAttributeMaxDynamicSharedMemorySize, LDS_BYTES) != hipSuccess) { fprintf(stderr, "kernel_launch: hipFuncSetAttribute failed\n"); grid = -1; return; }
        if (hipOccupancyMaxActiveBlocksPerMultiprocessor(&per_cu, (const void*)hymba_fwd, NTHR, LDS_BYTES) != hipSuccess || per_cu < 1) { fprintf(stderr, "kernel_launch: occupancy query says %d blocks per CU\n", per_cu); (void)hipGetLastError(); grid = -1; return; }
        grid = cus;
    }
    if (grid < 0) return;
    (void)hipMemsetAsync((char*)d_ws + WS_CTL, 0, CTL_ZERO_BYTES, stream);
    Args a{};
    for (int i = 0; i < 14; ++i) a.in[i] = (const float*)d_in[i];
    a.out = (float*)d_out; a.ws = (unsigned char*)d_ws;
#if MK_SINGLE
    a.ph_lo = 0; a.ph_hi = NPHASE;
    void* kargs[] = {&a};
    hipError_t e = hipLaunchCooperativeKernel((const void*)hymba_fwd, dim3(grid), dim3(NTHR), kargs, LDS_BYTES, stream);
    if (e != hipSuccess) fprintf(stderr, "kernel_launch: cooperative launch failed: %s (grid %d)\n", hipGetErrorString(e), grid);
#else
    for (int p = 0; p < NPHASE; ++p) { a.ph_lo = p; a.ph_hi = p + 1; hipLaunchKernelGGL(hymba_fwd, dim3(grid), dim3(NTHR), LDS_BYTES, stream, a); }
#endif
}
```
